# Optimizing an MI355X kernel written in HIP

```python
import math
import jax, jax.numpy as jnp
from jax import lax
import numpy as np

D_MODEL = 1024
BATCH = 16
SEQ = 2048
DEPTH = 2

CTX_LEN = 256
GRID_W = 64
N_MIXERS = 4
GROUP_W = D_MODEL // N_MIXERS
D_MIX = GROUP_W * N_MIXERS
HEAD_DIM = 64
HG_DK = 64
HG_DV = 64
HG_HEADS = GROUP_W // HG_DV
HG_CHUNK = 64
GA_HEADS = GROUP_W // HEAD_DIM
GA_KV = GA_HEADS // 2
DF_V = 64
DF_QK = DF_V // 2
DF_HEADS = GROUP_W // DF_V
WN_HEADS = GROUP_W // HEAD_DIM
WN_KV = WN_HEADS // 2
WINDOW = 128
Q_BLOCK = 128
ROPE_THETA = 10000.0
LN_EPS = 1e-5
RMS_EPS = 1e-6

IN_WIDTHS = (
    HG_HEADS * HG_DK, HG_HEADS * HG_DV, HG_HEADS * HG_DK, HG_HEADS * HG_DK,
    GA_HEADS * HEAD_DIM, GA_KV * HEAD_DIM, GA_KV * HEAD_DIM,
    DF_HEADS * 2 * DF_QK, DF_HEADS * 2 * DF_QK, DF_HEADS * DF_V,
    WN_HEADS * HEAD_DIM, WN_KV * HEAD_DIM, WN_KV * HEAD_DIM,
    D_MIX,
)
IN_WIDTH = sum(IN_WIDTHS)
SPLIT_AT = tuple(int(v) for v in np.cumsum(IN_WIDTHS)[:-1])

kernel_name = "hybrid_parallel_groups_dit_block"


def rms_norm(x, g):
    xf = x.astype(jnp.float32)
    y = xf * lax.rsqrt(jnp.mean(xf * xf, axis=-1, keepdims=True) + RMS_EPS)
    return (y * g).astype(x.dtype)


def layer_norm(x, g, b):
    xf = x.astype(jnp.float32)
    mu = jnp.mean(xf, axis=-1, keepdims=True)
    var = jnp.mean(jnp.square(xf - mu), axis=-1, keepdims=True)
    return ((xf - mu) * lax.rsqrt(var + LN_EPS) * g + b).astype(x.dtype)


def split_heads(t, n_heads):
    return t.reshape(t.shape[:-1] + (n_heads, t.shape[-1] // n_heads))


def merge_heads(t):
    return t.reshape(t.shape[:2] + (-1,))


def axial_rope(n_tok, dim):
    rows = n_tok // GRID_W
    row = jnp.repeat(jnp.arange(rows, dtype=jnp.float32), GRID_W)
    col = jnp.broadcast_to(jnp.arange(GRID_W, dtype=jnp.float32), (rows, GRID_W)).reshape(-1)
    d_axis = dim // 2
    inv = ROPE_THETA ** (-jnp.arange(0, d_axis, 2, dtype=jnp.float32) / d_axis)
    ang_r = row[:, None] * inv
    ang_c = col[:, None] * inv
    ang = jnp.concatenate([ang_r, ang_r, ang_c, ang_c], axis=-1)
    return jnp.cos(ang), jnp.sin(ang)


def apply_rope(x, rope):
    cos, sin = rope
    a1, a2, b1, b2 = jnp.split(x, 4, axis=-1)
    rot = jnp.concatenate([-a2, a1, -b2, b1], axis=-1)
    return (x * cos[:, None, :] + rot * sin[:, None, :]).astype(x.dtype)


def sweep_query_blocks(fn, q):
    b, s = q.shape[0], q.shape[1]
    nb = s // Q_BLOCK
    qb = jnp.moveaxis(q.reshape((b, nb, Q_BLOCK) + q.shape[2:]), 1, 0)
    out = lax.map(fn, qb)
    return jnp.moveaxis(out, 0, 1).reshape((b, s) + out.shape[3:])


def hgrn_forget(z, lb):
    f = lb + (1.0 - lb) * jax.nn.sigmoid(z.astype(jnp.float32))
    return (1.0 - f).astype(z.dtype), jnp.log(f)


def gla_chunk_scan(q, k, v, logf, s0):
    b, t, h, _ = q.shape
    dv = v.shape[-1]
    nc = t // HG_CHUNK

    def to_chunks(a):
        return jnp.moveaxis(a.reshape(b, nc, HG_CHUNK, h, a.shape[-1]), 1, 0)

    incl = jnp.tril(jnp.ones((HG_CHUNK, HG_CHUNK), dtype=bool))

    def step(s, xs):
        qc, kc, vc, fc = xs
        qf, kf, vf = qc.astype(jnp.float32), kc.astype(jnp.float32), vc.astype(jnp.float32)
        bcum = jnp.cumsum(fc, axis=1)
        o_inter = jnp.einsum('bthk,bhkv->bthv', qf * jnp.exp(bcum), s)
        diff = bcum[:, :, None] - bcum[:, None, :]
        decay = jnp.exp(jnp.where(incl[None, :, :, None, None], diff, -jnp.inf))
        att = jnp.einsum('bthk,bshk,btshk->bhts', qf, kf, decay)
        o_intra = jnp.einsum('bhts,bshv->bthv', att, vf)
        blast = bcum[:, -1]
        s_new = jnp.exp(blast)[..., None] * s + jnp.einsum(
            'bshk,bshv->bhkv', kf * jnp.exp(blast[:, None] - bcum), vf)
        return s_new, (o_inter + o_intra).astype(v.dtype)

    s_fin, o = lax.scan(step, s0, (to_chunks(q), to_chunks(k), to_chunks(v), to_chunks(logf)))
    return jnp.moveaxis(o, 0, 1).reshape(b, t, h, dv), s_fin


def gla_final_state(k, v, logf):
    after = lax.cumsum(logf, axis=1, reverse=True) - logf
    return jnp.einsum('bshk,bshv->bhkv', k.astype(jnp.float32) * jnp.exp(after), v.astype(jnp.float32))


def hgrn2_mixer(q, i, f_fwd, f_bwd, qc, ic, fc_fwd, fc_bwd, lb, norm_g, ctx_out):
    hs = lambda t: split_heads(t, HG_HEADS)
    flip = lambda t: jnp.flip(t, axis=1)
    q, qc = jax.nn.silu(hs(q)), jax.nn.silu(hs(qc))
    i, ic = hs(i), hs(ic)
    lb_f = lb[0].reshape(HG_HEADS, HG_DK)
    lb_b = lb[1].reshape(HG_HEADS, HG_DK)
    k_f, lf_f = hgrn_forget(hs(f_fwd), lb_f)
    k_b, lf_b = hgrn_forget(hs(f_bwd), lb_b)
    kc_f, lfc_f = hgrn_forget(hs(fc_fwd), lb_f)
    kc_b, lfc_b = hgrn_forget(hs(fc_bwd), lb_b)
    b = qc.shape[0]
    if ctx_out:
        zeros = jnp.zeros((b, HG_HEADS, HG_DK, HG_DV), jnp.float32)
        oc_f, s_cf = gla_chunk_scan(qc, kc_f, ic, lfc_f, zeros)
        oc_b, s_cb = gla_chunk_scan(flip(qc), flip(kc_b), flip(ic), flip(lfc_b), zeros)
        yc = merge_heads(rms_norm(oc_f + flip(oc_b), norm_g))
    else:
        s_cf = gla_final_state(kc_f, ic, lfc_f)
        s_cb = gla_final_state(flip(kc_b), flip(ic), flip(lfc_b))
        yc = None
    o_f, _ = gla_chunk_scan(q, k_f, i, lf_f, s_cf)
    o_b, _ = gla_chunk_scan(flip(q), flip(k_b), flip(i), flip(lf_b), s_cb)
    y = merge_heads(rms_norm(o_f + flip(o_b), norm_g))
    return y, yc


def global_gqa(q, k, v, sink=None):
    b, s, h, d = q.shape
    kv = k.shape[2]
    g = h // kv
    scale = d ** -0.5
    qg = q.reshape(b, s, kv, g, d)

    def block(qb):
        logits = jnp.einsum('bqkgd,btkd->bkgqt', qb, k).astype(jnp.float32) * scale
        if sink is None:
            p = jax.nn.softmax(logits, axis=-1)
        else:
            col = jnp.broadcast_to(sink.astype(jnp.float32).reshape(kv, g)[None, :, :, None, None],
                                   logits.shape[:-1] + (1,))
            p = jax.nn.softmax(jnp.concatenate([logits, col], axis=-1), axis=-1)[..., :-1]
        return jnp.einsum('bkgqt,btkd->bqkgd', p.astype(v.dtype), v)

    return sweep_query_blocks(block, qg).reshape(b, s, h, d)


def diff_attention(q, k, v, lam, lam_init, subln_g):
    scale = q.shape[-1] ** -0.5

    def block(qb):
        logits = jnp.einsum('bqhmd,bthmd->bhmqt', qb, k).astype(jnp.float32) * scale
        p = jax.nn.softmax(logits, axis=-1)
        w = p[:, :, 0] - lam * p[:, :, 1]
        return jnp.einsum('bhqt,bthd->bqhd', w.astype(v.dtype), v)

    o = sweep_query_blocks(block, q)
    return rms_norm(o, subln_g) * (1.0 - lam_init)


def window_gqa_latent(q, k, v, k_ctx, v_ctx, sink):
    b, s, h, d = q.shape
    kv = k.shape[2]
    g = h // kv
    nb = s // Q_BLOCK
    scale = d ** -0.5

    def banded(t):
        tp = jnp.pad(t, ((0, 0), (Q_BLOCK, Q_BLOCK), (0, 0), (0, 0)))
        tb = tp.reshape(b, nb + 2, Q_BLOCK, kv, d)
        return jnp.concatenate([tb[:, :-2], tb[:, 1:-1], tb[:, 2:]], axis=2)

    kb, vb = banded(k), banded(v)
    qb = q.reshape(b, nb, Q_BLOCK, kv, g, d)
    blk = jnp.arange(nb)[:, None, None]
    qpos = blk * Q_BLOCK + jnp.arange(Q_BLOCK)[None, :, None]
    kpos = (blk - 1) * Q_BLOCK + jnp.arange(3 * Q_BLOCK)[None, None, :]
    allowed = (jnp.abs(kpos - qpos) <= WINDOW) & (kpos >= 0) & (kpos < s)
    lw = jnp.einsum('bnqkgd,bnskd->bnkgqs', qb, kb).astype(jnp.float32) * scale
    lw = jnp.where(allowed[None, :, None, None], lw, -jnp.inf)
    lc = jnp.einsum('bnqkgd,bskd->bnkgqs', qb, k_ctx).astype(jnp.float32) * scale
    ls = jnp.broadcast_to(sink.astype(jnp.float32).reshape(kv, g)[None, None, :, :, None, None],
                          lw.shape[:-1] + (1,))
    p = jax.nn.softmax(jnp.concatenate([lw, lc, ls], axis=-1), axis=-1).astype(v.dtype)
    n_w = 3 * Q_BLOCK
    n_c = k_ctx.shape[1]
    o = (jnp.einsum('bnkgqs,bnskd->bnqkgd', p[..., :n_w], vb)
         + jnp.einsum('bnkgqs,bskd->bnqkgd', p[..., n_w:n_w + n_c], v_ctx))
    return o.reshape(b, s, h, d)


def mixer_layer(x, cx, c, c_ctx, w_in, w_out, w_ada, b_ada, ln_g, ln_b, lb, hg_norm_g,
                ga_qn, ga_kn, df_lam, df_subln_g, wn_sink, rope64, rope32, layer_idx, ctx_out):
    alpha = (2.0 * DEPTH) ** 0.25
    shift, scale, gate = jnp.split(jax.nn.silu(c) @ w_ada + b_ada, 3, axis=-1)
    shift_c, scale_c, gate_c = jnp.split(jax.nn.silu(c_ctx) @ w_ada + b_ada, 3, axis=-1)
    h = x * (1.0 + scale[:, None]) + shift[:, None]
    hc = cx * (1.0 + scale_c) + shift_c
    (a_q, a_i, a_ff, a_fb, b_q, b_k, b_v, c_q, c_k, c_v, d_q, d_k, d_v, g_lat) = jnp.split(h @ w_in, SPLIT_AT, axis=-1)
    (a_qc, a_ic, a_ffc, a_fbc, b_qc, b_kc, b_vc, c_qc, c_kc, c_vc, d_qc, d_kc, d_vc, g_ctx) = jnp.split(hc @ w_in, SPLIT_AT, axis=-1)

    y_a, yc_a = hgrn2_mixer(a_q, a_i, a_ff, a_fb, a_qc, a_ic, a_ffc, a_fbc, lb, hg_norm_g, ctx_out)

    qB = apply_rope(rms_norm(split_heads(b_q, GA_HEADS), ga_qn), rope64)
    kB = apply_rope(rms_norm(split_heads(b_k, GA_KV), ga_kn), rope64)
    vB = split_heads(b_v, GA_KV)
    kBc = rms_norm(split_heads(b_kc, GA_KV), ga_kn)
    vBc = split_heads(b_vc, GA_KV)
    y_b = merge_heads(global_gqa(qB, jnp.concatenate([kB, kBc], 1), jnp.concatenate([vB, vBc], 1)))

    bsz, n = x.shape[0], x.shape[1]
    n_ctx = cx.shape[1]
    def diff_qk(t, length, rotate):
        t = t.reshape(bsz, length, DF_HEADS * 2, DF_QK)
        if rotate:
            t = apply_rope(t, rope32)
        return t.reshape(bsz, length, DF_HEADS, 2, DF_QK)
    lam_init = 0.8 - 0.6 * math.exp(-0.3 * layer_idx)
    lamf = df_lam.astype(jnp.float32)
    lam = jnp.exp(jnp.sum(lamf[0] * lamf[1])) - jnp.exp(jnp.sum(lamf[2] * lamf[3])) + lam_init
    qC, kC, vC = diff_qk(c_q, n, True), diff_qk(c_k, n, True), split_heads(c_v, DF_HEADS)
    kCc, vCc = diff_qk(c_kc, n_ctx, False), split_heads(c_vc, DF_HEADS)
    y_c = merge_heads(diff_attention(qC, jnp.concatenate([kC, kCc], 1), jnp.concatenate([vC, vCc], 1),
                                     lam, lam_init, df_subln_g))

    qD = apply_rope(split_heads(d_q, WN_HEADS), rope64)
    kD = apply_rope(split_heads(d_k, WN_KV), rope64)
    vD = split_heads(d_v, WN_KV)
    kDc, vDc = split_heads(d_kc, WN_KV), split_heads(d_vc, WN_KV)
    y_d = merge_heads(window_gqa_latent(qD, kD, vD, kDc, vDc, wn_sink))

    y = jnp.concatenate([y_a, y_b, y_c, y_d], axis=-1) * jax.nn.silu(g_lat)
    x_new = layer_norm(alpha * x + gate[:, None] * (y @ w_out), ln_g, ln_b)
    if not ctx_out:
        return x_new, None

    yc_b = merge_heads(global_gqa(rms_norm(split_heads(b_qc, GA_HEADS), ga_qn), kBc, vBc))
    yc_c = merge_heads(diff_attention(diff_qk(c_qc, n_ctx, False), kCc, vCc, lam, lam_init, df_subln_g))
    yc_d = merge_heads(global_gqa(split_heads(d_qc, WN_HEADS), kDc, vDc, wn_sink))
    yc = jnp.concatenate([yc_a, yc_b, yc_c, yc_d], axis=-1) * jax.nn.silu(g_ctx)
    cx_new = layer_norm(alpha * cx + gate_c * (yc @ w_out), ln_g, ln_b)
    return x_new, cx_new


def setup_inputs(seed: int = 0) -> dict:
    key = jax.random.key(seed)
    ks = jax.random.split(key, 17)
    f32 = jnp.float32
    nrm = lambda k, shape, s: jax.random.normal(k, shape, f32) * s
    beta = (8.0 * DEPTH) ** -0.25
    return {
        "x": nrm(ks[0], (BATCH, SEQ, D_MODEL), 1.0),
        "c": nrm(ks[1], (BATCH, D_MODEL), 1.0),
        "ctx": nrm(ks[2], (BATCH, CTX_LEN, D_MODEL), 1.0),
        "c_ctx": nrm(ks[3], (D_MODEL,), 1.0),
        "w_in": nrm(ks[4], (DEPTH, D_MODEL, IN_WIDTH), D_MODEL ** -0.5),
        "w_out": nrm(ks[5], (DEPTH, D_MIX, D_MODEL), (D_MIX ** -0.5) * beta),
        "w_ada": nrm(ks[6], (DEPTH, D_MODEL, 3 * D_MODEL), 0.5 * D_MODEL ** -0.5),
        "b_ada": nrm(ks[7], (DEPTH, 3 * D_MODEL), 0.02),
        "ln_g": 1.0 + nrm(ks[8], (DEPTH, D_MODEL), 0.02),
        "ln_b": nrm(ks[9], (DEPTH, D_MODEL), 0.02),
        "hg_lb_logits": nrm(ks[10], (DEPTH, 2, HG_HEADS * HG_DK), 0.1),
        "hg_norm_g": 1.0 + nrm(ks[11], (DEPTH, HG_DV), 0.02),
        "ga_q_norm_g": 1.0 + nrm(ks[12], (DEPTH, HEAD_DIM), 0.02),
        "ga_k_norm_g": 1.0 + nrm(ks[13], (DEPTH, HEAD_DIM), 0.02),
        "df_lambda": nrm(ks[14], (DEPTH, 4, DF_QK), 0.1),
        "df_subln_g": 1.0 + nrm(ks[15], (DEPTH, DF_V), 0.02),
        "wn_sink": nrm(ks[16], (DEPTH, WN_HEADS), 0.5),
    }


def reference(x, c, ctx, c_ctx, w_in, w_out, w_ada, b_ada, ln_g, ln_b, hg_lb_logits, hg_norm_g,
              ga_q_norm_g, ga_k_norm_g, df_lambda, df_subln_g, wn_sink):
    n = x.shape[1]
    rope64 = axial_rope(n, HEAD_DIM)
    rope32 = axial_rope(n, DF_QK)
    lb_sm = jax.nn.softmax(hg_lb_logits.astype(jnp.float32), axis=0)
    lower_bounds = jnp.cumsum(lb_sm, axis=0) - lb_sm[0]
    cx = ctx
    for l in range(DEPTH):
        x, cx = mixer_layer(x, cx, c, c_ctx, w_in[l], w_out[l], w_ada[l], b_ada[l], ln_g[l], ln_b[l],
                            lower_bounds[l], hg_norm_g[l], ga_q_norm_g[l], ga_k_norm_g[l], df_lambda[l],
                            df_subln_g[l], wn_sink[l], rope64, rope32, l, l < DEPTH - 1)
    return x
```

```cpp
#include <hip/hip_runtime.h>
#include <hip/hip_cooperative_groups.h>
#include <cstdio>
namespace cg = cooperative_groups;

typedef unsigned short u16;
typedef __attribute__((ext_vector_type(8))) short bf16x8;
typedef __attribute__((ext_vector_type(4))) float f32x4;
#define DI __device__ __forceinline__
#define MFMA(a, b, c) __builtin_amdgcn_mfma_f32_16x16x32_bf16((a), (b), (c), 0, 0, 0)

#ifndef REP_INPROJ
#define REP_INPROJ 1
#endif
#ifndef REP_MIX
#define REP_MIX 1
#endif
#ifndef REP_OUT
#define REP_OUT 1
#endif
#ifndef MULTI_LAUNCH
#define MULTI_LAUNCH 0
#endif

constexpr int NB = 16, SEQ = 2048, LC = 256, T = 2304, DM = 1024, NIN = 3840;
constexpr int MLAT = NB * SEQ;
constexpr int MALL = MLAT + NB * LC;
constexpr int LDS_BYTES = 147456;
constexpr int NT = 512;
constexpr int NPHASE = 10;
constexpr float LOG2E = 1.4426950408889634f;

struct P {
  const float *x, *c, *ctx, *c_ctx, *w_in, *w_out, *w_ada, *b_ada, *ln_g, *ln_b, *lb_logits, *hg_norm_g, *ga_qn, *ga_kn,
      *df_lam, *df_subln, *wn_sink;
  float* out;
  u16 *Wt, *Wot, *H, *slab, *G;
  float *mod, *OF, *OB;
  int* ctr;
  unsigned* xbar;
  int pb, pe;
};

typedef __bf16 bf2_t __attribute__((ext_vector_type(2)));
typedef float f2_t __attribute__((ext_vector_type(2)));
DI unsigned pack2(float a, float b) {
  f2_t v = {a, b};
  return __builtin_bit_cast(unsigned, __builtin_convertvector(v, bf2_t));
}
DI u16 f2bf(float x) { return (u16)pack2(x, 0.f); }
DI float bflo(unsigned w) { return __uint_as_float(w << 16); }
DI float bfhi(unsigned w) { return __uint_as_float(w & 0xffff0000u); }
DI float hflo(unsigned w) { return (float)__builtin_bit_cast(_Float16, (u16)(w & 0xffffu)); }
DI float hfhi(unsigned w) { return (float)__builtin_bit_cast(_Float16, (u16)(w >> 16)); }
DI u16 f2h(float x) { return __builtin_bit_cast(u16, (_Float16)x); }
DI float silu(float v) { return v * __builtin_amdgcn_rcpf(1.f + __builtin_amdgcn_exp2f(-1.4426950408889634f * v)); }
DI void sincos_rev(float ang, float& s, float& c) {
  float rev = ang * 0.15915494309189535f;
  rev -= rintf(rev);
  s = __builtin_amdgcn_sinf(rev);
  c = __builtin_amdgcn_cosf(rev);
}
DI u16* slab_ptr(const P& p, int sidx, int b) { return p.slab + (size_t)(sidx * 16 + b) * (size_t)(T * 64); }
DI int tidx() { int t = threadIdx.x; asm volatile("" : "+v"(t)); return t; }
DI f32x4 zero4() { f32x4 z = {0.f, 0.f, 0.f, 0.f}; return z; }

DI void mod_item(const P& p, int item, char* lds) {
  const int tid = tidx(), lane = tid & 63, w = tid >> 6;
  const int l = item / 96, cb = item % 96;
  float* sv = (float*)lds;
  for (int i = tid; i < 17 * 1024; i += NT) {
    int r = i >> 10, k = i & 1023;
    float v = r < 16 ? p.c[r * 1024 + k] : p.c_ctx[k];
    sv[i] = silu(v);
  }
  __syncthreads();
  const int c = tid & 31, ks = tid >> 5, n = cb * 32 + c;
  const float* W = p.w_ada + (size_t)l * 1024 * 3072 + n;
  float acc[17];
#pragma unroll
  for (int r = 0; r < 17; ++r) acc[r] = 0.f;
  for (int k = ks * 64; k < ks * 64 + 64; k += 8) {
    float wv[8];
#pragma unroll
    for (int u = 0; u < 8; ++u) wv[u] = W[(size_t)(k + u) * 3072];
#pragma unroll
    for (int u = 0; u < 8; ++u)
#pragma unroll
      for (int r = 0; r < 17; ++r) acc[r] += sv[r * 1024 + k + u] * wv[u];
  }
#pragma unroll
  for (int r = 0; r < 17; ++r) acc[r] += __shfl_xor(acc[r], 32);
  __syncthreads();
  float* red = (float*)lds;
  if (lane < 32) {
#pragma unroll
    for (int r = 0; r < 17; ++r) red[(w * 17 + r) * 32 + c] = acc[r];
  }
  __syncthreads();
  for (int i = tid; i < 17 * 32; i += NT) {
    int r = i >> 5, cc = i & 31;
    float sum = 0.f;
#pragma unroll
    for (int ww = 0; ww < 8; ++ww) sum += red[(ww * 17 + r) * 32 + cc];
    int nn = cb * 32 + cc;
    p.mod[(size_t)(l * 17 + r) * 3072 + nn] = sum + p.b_ada[l * 3072 + nn];
  }
  __syncthreads();
}

DI void transpose_item(const float* __restrict__ W, u16* __restrict__ Wt, int N, int kt, int nt, char* lds) {
  const int tid = tidx();
  u16* tile = (u16*)lds;
  if (tid < 256) {
    const int r = tid >> 2, cs = (tid & 3) * 16;
    const float* src = W + (size_t)(kt * 64 + r) * N + nt * 64 + cs;
#pragma unroll
    for (int q = 0; q < 4; ++q) {
      float4 v = *(const float4*)(src + q * 4);
      tile[(cs + q * 4 + 0) * 72 + r] = f2bf(v.x);
      tile[(cs + q * 4 + 1) * 72 + r] = f2bf(v.y);
      tile[(cs + q * 4 + 2) * 72 + r] = f2bf(v.z);
      tile[(cs + q * 4 + 3) * 72 + r] = f2bf(v.w);
    }
  }
  __syncthreads();
  if (tid < 256) {
    const int n = tid >> 2, ks = (tid & 3) * 16;
    uint4 a = *(const uint4*)&tile[n * 72 + ks];
    uint4 b = *(const uint4*)&tile[n * 72 + ks + 8];
    u16* dst = Wt + (size_t)(nt * 64 + n) * 1024 + kt * 64 + ks;
    *(uint4*)dst = a;
    *(uint4*)(dst + 8) = b;
  }
  __syncthreads();
}

DI void phase_prep(const P& p, char* lds) {
  for (int it = blockIdx.x; it < 192 + 1920 + 512; it += gridDim.x) {
    if (it < 192) {
      mod_item(p, it, lds);
    } else if (it < 192 + 1920) {
      int t = it - 192;
      int l = t / 960, rem = t % 960;
      int kt = rem / 60, nt = rem % 60;
      transpose_item(p.w_in + (size_t)l * 1024 * NIN, p.Wt + (size_t)l * NIN * 1024, NIN, kt, nt, lds);
    } else {
      int t = it - 192 - 1920;
      int l = t >> 8, rem = t & 255;
      int kt = rem >> 4, nt = rem & 15;
      transpose_item(p.w_out + (size_t)l * 1024 * 1024, p.Wot + (size_t)l * 1024 * 1024, 1024, kt, nt, lds);
    }
  }
}

DI void phase_h0(const P& p) {
  const int tid = tidx(), lane = tid & 63, w = tid >> 6;
  const int gw = blockIdx.x * 8 + w, nw = gridDim.x * 8;
  const int per = (MALL + nw - 1) / nw;
  const int r0 = gw * per, r1 = (r0 + per < MALL) ? r0 + per : MALL;
  int cur_mr = -1;
  float4 sh[4], sc[4];
  for (int row = r0; row < r1; row += 2) {
    const bool two = row + 1 < r1;
    const int rowb = two ? row + 1 : row;
    const float* sa = row < MLAT ? p.x + (size_t)row * 1024 : p.ctx + (size_t)(row - MLAT) * 1024;
    const float* sb = rowb < MLAT ? p.x + (size_t)rowb * 1024 : p.ctx + (size_t)(rowb - MLAT) * 1024;
    float4 va[4], vb[4];
#pragma unroll
    for (int i = 0; i < 4; ++i) {
      va[i] = *(const float4*)(sa + i * 256 + lane * 4);
      vb[i] = *(const float4*)(sb + i * 256 + lane * 4);
    }
#pragma unroll
    for (int half = 0; half < 2; ++half) {
      const int rr = half ? rowb : row;
      if (half && !two) break;
      const int mr = rr < MLAT ? (rr >> 11) : 16;
      if (mr != cur_mr) {
        cur_mr = mr;
        const float* md = p.mod + (size_t)mr * 3072;
#pragma unroll
        for (int i = 0; i < 4; ++i) {
          sh[i] = *(const float4*)(md + i * 256 + lane * 4);
          sc[i] = *(const float4*)(md + 1024 + i * 256 + lane * 4);
        }
      }
#pragma unroll
      for (int i = 0; i < 4; ++i) {
        const float4 v = half ? vb[i] : va[i];
        uint2 o;
        o.x = pack2(v.x * (1.f + sc[i].x) + sh[i].x, v.y * (1.f + sc[i].y) + sh[i].y);
        o.y = pack2(v.z * (1.f + sc[i].z) + sh[i].z, v.w * (1.f + sc[i].w) + sh[i].w);
        *(uint2*)(p.H + (size_t)rr * 1024 + i * 256 + lane * 4) = o;
      }
    }
  }
}

template <int EPI>
DI bool tile_coords(int j, int mpx, int& m0, int& n0) {
  const int x = blockIdx.x & 7, s = blockIdx.x >> 3, ns = gridDim.x >> 3;
  const int q = s + ns * j;
  if constexpr (EPI == 0) {
    if (q >= mpx * 15) return false;
    const int panel = q / 90, i = q % 90;
    const int nt = i / 6, mi = i % 6;
    m0 = (x * mpx + panel * 6 + mi) * 256;
    n0 = nt * 256;
  } else {
    if (q >= mpx * 4) return false;
    m0 = (x * mpx + (q >> 2)) * 256;
    n0 = (q & 3) * 256;
  }
  return true;
}

template <int EPI>
DI void gemm_phase(const P& p, int l, const u16* __restrict__ A, const u16* __restrict__ Bt, int mpx, char* lds) {
  const int tid = tidx();
  int t = 0;
  int m0, n0;
  if (!tile_coords<EPI>(t, mpx, m0, n0)) return;
  const unsigned voffb = (unsigned)(((tid >> 3) * 1024 + (tid & 7) * 8) * 2);
  const u16* Ag = A + (size_t)m0 * 1024;
  const u16* Bg = Bt + (size_t)n0 * 1024;
  uint4 ra0, ra1, ra2, ra3, rb0, rb1, rb2, rb3;
#define GLOAD(AP, BP, k0)                                                       \
  ra0 = *(const uint4*)((const char*)((AP) + 0 * 64 * 1024 + (k0)) + voffb);   \
  ra1 = *(const uint4*)((const char*)((AP) + 1 * 64 * 1024 + (k0)) + voffb);   \
  ra2 = *(const uint4*)((const char*)((AP) + 2 * 64 * 1024 + (k0)) + voffb);   \
  ra3 = *(const uint4*)((const char*)((AP) + 3 * 64 * 1024 + (k0)) + voffb);   \
  rb0 = *(const uint4*)((const char*)((BP) + 0 * 64 * 1024 + (k0)) + voffb);   \
  rb1 = *(const uint4*)((const char*)((BP) + 1 * 64 * 1024 + (k0)) + voffb);   \
  rb2 = *(const uint4*)((const char*)((BP) + 2 * 64 * 1024 + (k0)) + voffb);   \
  rb3 = *(const uint4*)((const char*)((BP) + 3 * 64 * 1024 + (k0)) + voffb);
#define GSTORE(AS, BS)                       \
  *(uint4*)&(AS)[lw + 0 * 64 * 64] = ra0;    \
  *(uint4*)&(AS)[lw + 1 * 64 * 64] = ra1;    \
  *(uint4*)&(AS)[lw + 2 * 64 * 64] = ra2;    \
  *(uint4*)&(AS)[lw + 3 * 64 * 64] = ra3;    \
  *(uint4*)&(BS)[lw + 0 * 64 * 64] = rb0;    \
  *(uint4*)&(BS)[lw + 1 * 64 * 64] = rb1;    \
  *(uint4*)&(BS)[lw + 2 * 64 * 64] = rb2;    \
  *(uint4*)&(BS)[lw + 3 * 64 * 64] = rb3;
#define GCOMPUTE_KS(AS, BS, ks)                                                                                   \
  {                                                                                                               \
    bf16x8 bfr[4];                                                                                                \
    _Pragma("unroll") for (int ni = 0; ni < 4; ++ni) bfr[ni] = *(const bf16x8*)&(BS)[(wn * 64 + ni * 16 + r) * 64 + ((((ks) * 4 + g) ^ (r & 7)) * 8)]; \
    _Pragma("unroll") for (int mh = 0; mh < 2; ++mh) {                                                            \
      bf16x8 af[4];                                                                                               \
      _Pragma("unroll") for (int mi = 0; mi < 4; ++mi) af[mi] = *(const bf16x8*)&(AS)[(wm * 128 + (mh * 4 + mi) * 16 + r) * 64 + ((((ks) * 4 + g) ^ (r & 7)) * 8)];  \
      _Pragma("unroll") for (int mi = 0; mi < 4; ++mi)                                                            \
        _Pragma("unroll") for (int ni = 0; ni < 4; ++ni) acc[mh * 4 + mi][ni] = MFMA(af[mi], bfr[ni], acc[mh * 4 + mi][ni]);  \
    }                                                                                                             \
  }
#define GCOMPUTE(AS, BS) GCOMPUTE_KS(AS, BS, 0) GCOMPUTE_KS(AS, BS, 1)
  GLOAD(Ag, Bg, 0)
  u16* As0 = (u16*)lds;
  u16* Bs0 = As0 + 256 * 64;
  u16* As1 = Bs0 + 256 * 64;
  u16* Bs1 = As1 + 256 * 64;
  const int lw = (tid >> 3) * 64 + (((tid & 7) ^ ((tid >> 3) & 7)) * 8);
  GSTORE(As0, Bs0)
  while (true) {
  const int tn = t + 1;
  int m1 = 0, n1 = 0;
  const bool has_next = tile_coords<EPI>(tn, mpx, m1, n1);
  const u16* Agn = A + (size_t)m1 * 1024;
  const u16* Bgn = Bt + (size_t)n1 * 1024;
  f32x4 acc[8][4];
#pragma unroll
  for (int i = 0; i < 8; ++i)
#pragma unroll
    for (int j = 0; j < 4; ++j) acc[i][j] = zero4();
  {
  const int lane = tid & 63, w = tid >> 6, r = lane & 15, g = lane >> 4, wm = w >> 2, wn = w & 3;
  __syncthreads();
  GLOAD(Ag, Bg, 64)
  __builtin_amdgcn_sched_barrier(0);
  GCOMPUTE_KS(As0, Bs0, 0)
  __builtin_amdgcn_sched_barrier(0);
  GSTORE(As1, Bs1)
  GLOAD(Ag, Bg, 128)
  __builtin_amdgcn_sched_barrier(0);
  GCOMPUTE_KS(As0, Bs0, 1)
  __builtin_amdgcn_sched_barrier(0);
#pragma unroll 1
  for (int kk = 1; kk < 15; kk += 2) {
    __syncthreads();
    GSTORE(As0, Bs0)
    GLOAD(Ag, Bg, (kk + 2) * 64)
    __builtin_amdgcn_sched_barrier(0);
    GCOMPUTE(As1, Bs1)
    __builtin_amdgcn_sched_barrier(0);
    __syncthreads();
    GSTORE(As1, Bs1)
    {
      const bool in_tile = kk + 3 < 16;
      const u16* pa = in_tile ? Ag : Agn;
      const u16* pb = in_tile ? Bg : Bgn;
      const int k0 = in_tile ? (kk + 3) * 64 : 0;
      GLOAD(pa, pb, k0)
    }
    __builtin_amdgcn_sched_barrier(0);
    GCOMPUTE(As0, Bs0)
    __builtin_amdgcn_sched_barrier(0);
  }
  __syncthreads();
  __builtin_amdgcn_sched_barrier(0);
  GCOMPUTE(As1, Bs1)
  __builtin_amdgcn_sched_barrier(0);
  }
  __syncthreads();
  GSTORE(As0, Bs0)
  const int tid_e = tidx();
  const int lane = tid_e & 63, w = tid_e >> 6, r = lane & 15, g = lane >> 4, wm = w >> 2, wn = w & 3;
  if constexpr (EPI == 1) {
    const float alpha = 1.4142135623730951f;
    float* Cw = (float*)(lds + 65536) + w * (16 * 68);
    const int mr = m0 < MLAT ? (m0 >> 11) : 16;
    const int colw = n0 + wn * 64;
    const float* gate = p.mod + (size_t)(l * 17 + mr) * 3072 + 2048 + colw;
    const float* xr = ((l == 0) ? (m0 < MLAT ? p.x + (size_t)m0 * 1024 : p.ctx + (size_t)(m0 - MLAT) * 1024)
                                : p.out + (size_t)m0 * 1024) + (size_t)(wm * 128) * 1024 + colw;
    float* Z = (float*)p.slab + (size_t)(m0 + wm * 128) * 1024 + colw;
    const int c4 = (lane & 15) * 4, rr0 = lane >> 4;
    const float4 gt = *(const float4*)(gate + c4);
    float4 xn[4];
#pragma unroll
    for (int i = 0; i < 4; ++i) xn[i] = *(const float4*)(xr + (size_t)(rr0 + 4 * i) * 1024 + c4);
#pragma unroll
    for (int mi = 0; mi < 8; ++mi) {
      float4 xv[4];
#pragma unroll
      for (int i = 0; i < 4; ++i) xv[i] = xn[i];
      if (mi < 7) {
#pragma unroll
        for (int i = 0; i < 4; ++i) xn[i] = *(const float4*)(xr + (size_t)((mi + 1) * 16 + rr0 + 4 * i) * 1024 + c4);
      }
#pragma unroll
      for (int ni = 0; ni < 4; ++ni)
#pragma unroll
        for (int j = 0; j < 4; ++j) Cw[(g * 4 + j) * 68 + ni * 16 + r] = acc[mi][ni][j];
      __builtin_amdgcn_fence(__ATOMIC_RELEASE, "wavefront");
#pragma unroll
      for (int i = 0; i < 4; ++i) {
        const int row = rr0 + 4 * i;
        const float4 a = *(const float4*)&Cw[row * 68 + c4];
        float4 z;
        z.x = alpha * xv[i].x + gt.x * a.x;
        z.y = alpha * xv[i].y + gt.y * a.y;
        z.z = alpha * xv[i].z + gt.z * a.z;
        z.w = alpha * xv[i].w + gt.w * a.w;
        *(float4*)(Z + (size_t)(mi * 16 + row) * 1024 + c4) = z;
      }
      __builtin_amdgcn_fence(__ATOMIC_RELEASE, "wavefront");
    }
  } else {
    const int cb = n0 + wn * 64;
    const bool isctx = m0 >= MLAT;
    const int b = isctx ? ((m0 - MLAT) >> 8) : (m0 >> 11);
    const int tokw = (isctx ? 2048 + ((m0 - MLAT) & 255) : (m0 & 2047)) + wm * 128;
    u16* Tl = (u16*)(lds + 65536) + w * (64 * 72);
    int kind = 0;
    int tr = 0;
    bool donorm = false;
    if (cb >= 2816) { kind = 2; tr = 1; }
    else if (cb < 256) tr = 1;
    else if (cb < 512) tr = 0;
    else if (cb < 1024) tr = 2;
    else if (cb < 1408) { tr = 3; donorm = true; }
    else if (cb < 1536) kind = 1;
    else if (cb < 2048) tr = isctx ? 0 : 4;
    else if (cb < 2304) kind = 1;
    else if (cb < 2688) tr = isctx ? 0 : 3;
    else kind = 1;
    const float* gw = (cb < 1280 ? p.ga_qn : p.ga_kn) + l * 64;
    float gv0 = 1.f, gv1 = 1.f, gv2 = 1.f, gv3 = 1.f;
    if (donorm) { gv0 = gw[r]; gv1 = gw[16 + r]; gv2 = gw[32 + r]; gv3 = gw[48 + r]; }
    const bool dorope = (tr == 3) && !isctx;
    const float invf64 = exp2f(-13.287712379549449f * (float)r * (1.f / 16.f));
    const float invf32 = exp2f(-13.287712379549449f * (float)(r & 7) * (1.f / 8.f));
    const bool lo8 = r < 8;
    u16* dst;
    size_t rstride;
    if (kind == 2) {
      dst = p.G + (size_t)(m0 + wm * 128) * 1024 + (cb - 2816);
      rstride = 1024;
    } else if (kind == 1) {
      dst = slab_ptr(p, cb >> 6, b) + tokw;
      rstride = T;
    } else {
      dst = slab_ptr(p, cb >> 6, b) + (size_t)tokw * 64;
      rstride = 64;
    }
#pragma unroll
    for (int hf = 0; hf < 2; ++hf) {
#pragma unroll
      for (int mi = 0; mi < 4; ++mi) {
#pragma unroll
        for (int j = 0; j < 4; ++j) {
          float v0 = acc[hf * 4 + mi][0][j], v1 = acc[hf * 4 + mi][1][j], v2 = acc[hf * 4 + mi][2][j], v3 = acc[hf * 4 + mi][3][j];
          const int rowl = mi * 16 + g * 4 + j;
          const int s = tokw + hf * 64 + rowl;
          if (tr == 1) {
            v0 = silu(v0); v1 = silu(v1); v2 = silu(v2); v3 = silu(v3);
          } else if (tr == 3) {
            if (donorm) {
              float ss = v0 * v0 + v1 * v1 + v2 * v2 + v3 * v3;
              ss += __shfl_xor(ss, 1);
              ss += __shfl_xor(ss, 2);
              ss += __shfl_xor(ss, 4);
              ss += __shfl_xor(ss, 8);
              const float inv = rsqrtf(ss * (1.f / 64.f) + 1e-6f);
              v0 *= inv * gv0; v1 *= inv * gv1; v2 *= inv * gv2; v3 *= inv * gv3;
            }
            if (dorope) {
              float sr, cr, sc, cc;
              sincos_rev((float)(s >> 6) * invf64, sr, cr);
              sincos_rev((float)(s & 63) * invf64, sc, cc);
              const float a1 = v0, a2 = v1, b1 = v2, b2 = v3;
              v0 = a1 * cr - a2 * sr;
              v1 = a2 * cr + a1 * sr;
              v2 = b1 * cc - b2 * sc;
              v3 = b2 * cc + b1 * sc;
            }
          } else if (tr == 4) {
            float sr, cr, sc, cc;
            sincos_rev((float)(s >> 6) * invf32, sr, cr);
            sincos_rev((float)(s & 63) * invf32, sc, cc);
            const float p0 = __shfl_xor(v0, 8), p1 = __shfl_xor(v1, 8), p2 = __shfl_xor(v2, 8), p3 = __shfl_xor(v3, 8);
            v0 = lo8 ? (v0 * cr - p0 * sr) : (v0 * cr + p0 * sr);
            v1 = lo8 ? (v1 * cc - p1 * sc) : (v1 * cc + p1 * sc);
            v2 = lo8 ? (v2 * cr - p2 * sr) : (v2 * cr + p2 * sr);
            v3 = lo8 ? (v3 * cc - p3 * sc) : (v3 * cc + p3 * sc);
          }
          const unsigned u01 = pack2(v0, v1), u23 = pack2(v2, v3);
          if (kind == 1) {
            Tl[(0 * 16 + r) * 72 + rowl] = (u16)u01;
            Tl[(1 * 16 + r) * 72 + rowl] = (u16)(u01 >> 16);
            Tl[(2 * 16 + r) * 72 + rowl] = (u16)u23;
            Tl[(3 * 16 + r) * 72 + rowl] = (u16)(u23 >> 16);
          } else if (tr == 2) {
            Tl[rowl * 72 + 0 * 16 + r] = f2h(v0);
            Tl[rowl * 72 + 1 * 16 + r] = f2h(v1);
            Tl[rowl * 72 + 2 * 16 + r] = f2h(v2);
            Tl[rowl * 72 + 3 * 16 + r] = f2h(v3);
          } else {
            Tl[rowl * 72 + 0 * 16 + r] = (u16)u01;
            Tl[rowl * 72 + 1 * 16 + r] = (u16)(u01 >> 16);
            Tl[rowl * 72 + 2 * 16 + r] = (u16)u23;
            Tl[rowl * 72 + 3 * 16 + r] = (u16)(u23 >> 16);
          }
        }
      }
      __builtin_amdgcn_fence(__ATOMIC_RELEASE, "wavefront");
      u16* dh = (kind == 1) ? dst + hf * 64 : dst + (size_t)(hf * 64) * rstride;
#pragma unroll
      for (int i = 0; i < 8; ++i) {
        const int c = lane + i * 64;
        const int row = c >> 3, cc = c & 7;
        uint4 v = *(const uint4*)&Tl[row * 72 + cc * 8];
        *(uint4*)(dh + (size_t)row * rstride + cc * 8) = v;
      }
      __builtin_amdgcn_fence(__ATOMIC_RELEASE, "wavefront");
    }
  }
  __syncthreads();
  if (!has_next) break;
  t = tn; m0 = m1; n0 = n1; Ag = Agn; Bg = Bgn;
  }
}

DI void phase_inproj(const P& p, int l, char* lds) {
  gemm_phase<0>(p, l, p.H, p.Wt + (size_t)l * NIN * 1024, (MALL / 256) / 8, lds);
}
DI void phase_outproj(const P& p, int l, char* lds) {
  const int mrows = (l == 0) ? MALL : MLAT;
  gemm_phase<1>(p, l, p.H  , p.Wot + (size_t)l * 1024 * 1024, (mrows / 256) / 8, lds);
}

template <int MODE>
DI void attn_item(const P& p, const u16* __restrict__ Q0, const u16* __restrict__ Q1, const u16* __restrict__ Kp,
                  const u16* __restrict__ Vp, int qtok0, int ka0, int na, int kb0, int nb, bool window, float c1, bool has_sink,
                  float sink0, float sink1, int yrow0, int ycol0, float lam, const float* __restrict__ subln, float outscale,
                  char* lds) {
  const int tid = tidx(), lane = tid & 63, w = tid >> 6, r = lane & 15, g = lane >> 4;
  u16* Kbase = (u16*)lds;
  bf16x8 qf[2][2][2];
#pragma unroll
  for (int tt = 0; tt < 2; ++tt)
#pragma unroll
    for (int hh = 0; hh < 2; ++hh) {
      const int tok = qtok0 + w * 32 + tt * 16 + r;
      const u16* base = (hh ? Q1 : Q0) + (size_t)tok * 64;
      if constexpr (MODE == 0) {
        qf[tt][hh][0] = *(const bf16x8*)(base + g * 8);
        qf[tt][hh][1] = *(const bf16x8*)(base + 32 + g * 8);
      } else {
        qf[tt][hh][0] = *(const bf16x8*)(base + hh * 32 + g * 8);
        qf[tt][hh][1] = qf[tt][hh][0];
      }
    }
  f32x4 O[2][2][4];
  float lsum[2][2], nbias[2][2];
  bool first = true;
#pragma unroll
  for (int tt = 0; tt < 2; ++tt)
#pragma unroll
    for (int hh = 0; hh < 2; ++hh) {
      lsum[tt][hh] = 0.f;
      nbias[tt][hh] = 0.f;
#pragma unroll
      for (int dt = 0; dt < 4; ++dt) O[tt][hh][dt] = zero4();
    }
  const int ntile = na + nb;
  const int lrow = tid >> 3, lcc = (tid & 7) * 8;
  const unsigned kvoff = (unsigned)((lrow * 64 + lcc) * 2), vvoff = (unsigned)((lrow * T + lcc) * 2);
  const int krow = (lrow & 32) | (((lrow >> 2) & 1) * 16) | (((lrow >> 3) & 3) * 4) | (lrow & 3);
  const int kwoff = krow * 64 + (((tid & 7) ^ (krow & 7)) * 8);
  const int vwoff = lrow * 64 + (((tid & 7) ^ (lrow & 7)) * 8);
  uint4 kr0, vr0;
#define ALOAD(kt)                                                          \
  kr0 = *(const uint4*)((const char*)(Kp + (size_t)(kt) * 64) + kvoff);     \
  vr0 = *(const uint4*)((const char*)(Vp + (kt)) + vvoff);
  {
    const int kt0 = (0 < na) ? ka0 : kb0;
    ALOAD(kt0)
  }
  __syncthreads();
  *(uint4*)&Kbase[kwoff] = kr0;
  *(uint4*)&Kbase[64 * 64 + vwoff] = vr0;
  for (int it = 0; it < ntile; ++it) {
    const int kt0 = (it < na) ? ka0 + it * 64 : kb0 + (it - na) * 64;
    const bool masked = window && (it < na);
    const u16* Ks = Kbase + (it & 1) * (2 * 64 * 64);
    const u16* Vs = Ks + 64 * 64;
    __syncthreads();
    const bool more = it + 1 < ntile;
    if (more) {
      const int kn = (it + 1 < na) ? ka0 + (it + 1) * 64 : kb0 + (it + 1 - na) * 64;
      ALOAD(kn)
    }
    bool skip = false;
    if (masked) {
      const int qlo = qtok0 + __builtin_amdgcn_readfirstlane(w) * 32;
      skip = (kt0 > qlo + 31 + 128) || (kt0 + 63 < qlo - 128);
    }
    if (!skip) {
    f32x4 S[2][2][2][2];
#pragma unroll
    for (int kh = 0; kh < 2; ++kh) {
      bf16x8 kf[2][2];
#pragma unroll
      for (int t = 0; t < 2; ++t)
#pragma unroll
        for (int s2 = 0; s2 < 2; ++s2)
          kf[t][s2] = *(const bf16x8*)&Ks[(kh * 32 + t * 16 + r) * 64 + (((s2 * 4 + g) ^ (r & 7)) * 8)];
#pragma unroll
      for (int tt = 0; tt < 2; ++tt)
#pragma unroll
        for (int hh = 0; hh < 2; ++hh) {
          f32x4 s0 = zero4(), s1 = zero4();
          if constexpr (MODE == 0) {
            s0 = MFMA(kf[0][0], qf[tt][hh][0], s0);
            s1 = MFMA(kf[1][0], qf[tt][hh][0], s1);
            s0 = MFMA(kf[0][1], qf[tt][hh][1], s0);
            s1 = MFMA(kf[1][1], qf[tt][hh][1], s1);
          } else {
            s0 = MFMA(kf[0][hh], qf[tt][hh][0], s0);
            s1 = MFMA(kf[1][hh], qf[tt][hh][0], s1);
          }
          S[kh][tt][hh][0] = s0;
          S[kh][tt][hh][1] = s1;
        }
    }
    if (masked) {
#pragma unroll
      for (int kh = 0; kh < 2; ++kh)
#pragma unroll
        for (int tt = 0; tt < 2; ++tt) {
          const int qpos = qtok0 + w * 32 + tt * 16 + r;
          const int kp0 = kt0 + kh * 32 + g * 8;
#pragma unroll
          for (int t = 0; t < 2; ++t)
#pragma unroll
            for (int j = 0; j < 4; ++j) {
              int d = kp0 + t * 4 + j - qpos;
              d = d < 0 ? -d : d;
              if (d > 128) { S[kh][tt][0][t][j] = -INFINITY; S[kh][tt][1][t][j] = -INFINITY; }
            }
        }
    }
#pragma unroll
    for (int tt = 0; tt < 2; ++tt)
#pragma unroll
      for (int hh = 0; hh < 2; ++hh) {
        const float nb = nbias[tt][hh];
#pragma unroll
        for (int kh = 0; kh < 2; ++kh)
#pragma unroll
          for (int t = 0; t < 2; ++t) S[kh][tt][hh][t] = S[kh][tt][hh][t] * c1 + nb;
      }
    {
      float mxq[2][2];
      bool need = first;
#pragma unroll
      for (int tt = 0; tt < 2; ++tt)
#pragma unroll
        for (int hh = 0; hh < 2; ++hh) {
          const float m0 = fmaxf(fmaxf(S[0][tt][hh][0][0], S[0][tt][hh][0][1]), S[0][tt][hh][0][2]);
          const float m1 = fmaxf(fmaxf(S[0][tt][hh][1][0], S[0][tt][hh][1][1]), S[0][tt][hh][1][2]);
          const float m2 = fmaxf(fmaxf(S[1][tt][hh][0][0], S[1][tt][hh][0][1]), S[1][tt][hh][0][2]);
          const float m3 = fmaxf(fmaxf(S[1][tt][hh][1][0], S[1][tt][hh][1][1]), S[1][tt][hh][1][2]);
          const float m4 = fmaxf(fmaxf(S[0][tt][hh][0][3], S[0][tt][hh][1][3]), m0);
          const float m5 = fmaxf(fmaxf(S[1][tt][hh][0][3], S[1][tt][hh][1][3]), m1);
          mxq[tt][hh] = fmaxf(fmaxf(m2, m3), fmaxf(m4, m5));
          need = need || (mxq[tt][hh] > 8.f);
        }
      if (__builtin_amdgcn_ballot_w64(need) != 0) {
#pragma unroll
        for (int tt = 0; tt < 2; ++tt)
#pragma unroll
          for (int hh = 0; hh < 2; ++hh) {
            float mx = mxq[tt][hh];
            mx = fmaxf(mx, __shfl_xor(mx, 16));
            mx = fmaxf(mx, __shfl_xor(mx, 32));
            const float d = (mx == -INFINITY) ? 0.f : (first ? mx : fmaxf(mx, 0.f));
            const float alpha = __builtin_amdgcn_exp2f(-d);
            lsum[tt][hh] *= alpha;
            nbias[tt][hh] -= d;
#pragma unroll
            for (int dt = 0; dt < 4; ++dt)
#pragma unroll
              for (int j = 0; j < 4; ++j) O[tt][hh][dt][j] *= alpha;
#pragma unroll
            for (int kh = 0; kh < 2; ++kh)
#pragma unroll
              for (int t = 0; t < 2; ++t) S[kh][tt][hh][t] = S[kh][tt][hh][t] - d;
          }
      }
      first = false;
    }
#pragma unroll
    for (int kh = 0; kh < 2; ++kh) {
#pragma unroll
      for (int tt = 0; tt < 2; ++tt) {
        bf16x8 pf[2];
#pragma unroll
        for (int hh = 0; hh < 2; ++hh) {
          float pv[8];
#pragma unroll
          for (int j = 0; j < 4; ++j) {
            pv[j] = __builtin_amdgcn_exp2f(S[kh][tt][hh][0][j]);
            pv[4 + j] = __builtin_amdgcn_exp2f(S[kh][tt][hh][1][j]);
          }
          lsum[tt][hh] += ((pv[0] + pv[1]) + (pv[2] + pv[3])) + ((pv[4] + pv[5]) + (pv[6] + pv[7]));
          const uint4 pk = make_uint4(pack2(pv[0], pv[1]), pack2(pv[2], pv[3]), pack2(pv[4], pv[5]), pack2(pv[6], pv[7]));
          pf[hh] = __builtin_bit_cast(bf16x8, pk);
        }
#pragma unroll
        for (int dt = 0; dt < 4; ++dt) {
          const bf16x8 vf = *(const bf16x8*)&Vs[(dt * 16 + r) * 64 + (((kh * 4 + g) ^ (r & 7)) * 8)];
          O[tt][0][dt] = MFMA(vf, pf[0], O[tt][0][dt]);
          O[tt][1][dt] = MFMA(vf, pf[1], O[tt][1][dt]);
        }
      }
    }
    }
    if (more) {
      u16* Kn = Kbase + ((it + 1) & 1) * (2 * 64 * 64);
      *(uint4*)&Kn[kwoff] = kr0;
      *(uint4*)&Kn[64 * 64 + vwoff] = vr0;
    }
  }
  float linv[2][2];
#pragma unroll
  for (int tt = 0; tt < 2; ++tt)
#pragma unroll
    for (int hh = 0; hh < 2; ++hh) {
      float lt = lsum[tt][hh];
      lt += __shfl_xor(lt, 16);
      lt += __shfl_xor(lt, 32);
      if (has_sink) lt += __builtin_amdgcn_exp2f((hh ? sink1 : sink0) + nbias[tt][hh]);
      linv[tt][hh] = 1.f / lt;
    }
#pragma unroll
  for (int tt = 0; tt < 2; ++tt) {
    const int row = yrow0 + w * 32 + tt * 16 + r;
    if constexpr (MODE == 0) {
#pragma unroll
      for (int hh = 0; hh < 2; ++hh)
#pragma unroll
        for (int dt = 0; dt < 4; ++dt) {
          const int col = ycol0 + hh * 64 + dt * 16 + g * 4;
          const uint2 gg = *(const uint2*)(p.G + (size_t)row * 1024 + col);
          const float li = linv[tt][hh];
          uint2 o;
          o.x = pack2(O[tt][hh][dt][0] * li * bflo(gg.x), O[tt][hh][dt][1] * li * bfhi(gg.x));
          o.y = pack2(O[tt][hh][dt][2] * li * bflo(gg.y), O[tt][hh][dt][3] * li * bfhi(gg.y));
          *(uint2*)(p.H + (size_t)row * 1024 + col) = o;
        }
    } else {
      float ov[4][4];
      float ss = 0.f;
#pragma unroll
      for (int dt = 0; dt < 4; ++dt)
#pragma unroll
        for (int j = 0; j < 4; ++j) {
          const float v = O[tt][0][dt][j] * linv[tt][0] - lam * O[tt][1][dt][j] * linv[tt][1];
          ov[dt][j] = v;
          ss += v * v;
        }
      ss += __shfl_xor(ss, 16);
      ss += __shfl_xor(ss, 32);
      const float rinv = rsqrtf(ss * (1.f / 64.f) + 1e-6f) * outscale;
#pragma unroll
      for (int dt = 0; dt < 4; ++dt) {
        const int d = dt * 16 + g * 4;
        const int col = ycol0 + d;
        const uint2 gg = *(const uint2*)(p.G + (size_t)row * 1024 + col);
        const float4 sg = *(const float4*)(subln + d);
        uint2 o;
        o.x = pack2(ov[dt][0] * rinv * sg.x * bflo(gg.x), ov[dt][1] * rinv * sg.y * bfhi(gg.x));
        o.y = pack2(ov[dt][2] * rinv * sg.z * bflo(gg.y), ov[dt][3] * rinv * sg.w * bfhi(gg.y));
        *(uint2*)(p.H + (size_t)row * 1024 + col) = o;
      }
    }
  }
}

DI void hgrn_unit(const P& p, int l, int unit, char* lds_all) {
  const int tid512 = tidx();
  const int dir = tid512 >> 8;
  const int tid = tid512 & 255, lane = tid & 63, w = tid >> 6, r = lane & 15, g = lane >> 4;
  char* lds = lds_all + dir * 73728;
  const int b = unit >> 2, h = unit & 3;
  float* Lf = (float*)lds;
  float* Seg = Lf + 64 * 65;
  u16* Qm = (u16*)(Seg + 256);
  u16* Km = Qm + 64 * 72;
  u16* KmT = Km + 64 * 72;
  u16* Vt = KmT + 64 * 72;
  u16* Att = Vt + 64 * 72;
  u16* St = Att + 64 * 72;
  const u16* qs = slab_ptr(p, h, b);
  const u16* is = slab_ptr(p, 4 + h, b);
  const u16* zs = slab_ptr(p, 8 + dir * 4 + h, b);
  float* Og = (dir ? p.OB : p.OF) + (size_t)(b * 4 + h) * T * 64;
  const int tau = tid >> 2, kc = (tid & 3) * 16;
  float lbv[16];
#pragma unroll
  for (int i = 0; i < 16; ++i) {
    if (l == 0) {
      lbv[i] = 0.f;
    } else {
      const float e0 = p.lb_logits[(0 * 2 + dir) * 256 + h * 64 + kc + i];
      const float e1 = p.lb_logits[(1 * 2 + dir) * 256 + h * 64 + kc + i];
      lbv[i] = 1.f / (1.f + __expf(e0 - e1));
    }
  }
  f32x4 Sacc[4];
#pragma unroll
  for (int nt = 0; nt < 4; ++nt) Sacc[nt] = zero4();

  for (int c = 0; c < 36; ++c) {
    int base;
    if (c < 4) base = 2048 + (dir ? (3 - c) : c) * 64;
    else base = (dir ? (31 - (c - 4)) : (c - 4)) * 64;
    const int tok = base + (dir ? 63 - tau : tau);
    float qv[16], kk[16];
    {
      const uint4* qp = (const uint4*)(qs + (size_t)tok * 64 + kc);
      const uint4* zp = (const uint4*)(zs + (size_t)tok * 64 + kc);
      const uint4* vp = (const uint4*)(is + (size_t)tok * 64 + kc);
      const uint4 q0 = qp[0], q1 = qp[1], z0 = zp[0], z1 = zp[1], v0 = vp[0], v1 = vp[1];
      const unsigned qw[8] = {q0.x, q0.y, q0.z, q0.w, q1.x, q1.y, q1.z, q1.w};
      const unsigned zw[8] = {z0.x, z0.y, z0.z, z0.w, z1.x, z1.y, z1.z, z1.w};
      const unsigned vw[8] = {v0.x, v0.y, v0.z, v0.w, v1.x, v1.y, v1.z, v1.w};
#pragma unroll
      for (int e = 0; e < 8; ++e) {
        qv[2 * e] = bflo(qw[e]);
        qv[2 * e + 1] = bfhi(qw[e]);
        const float za = hflo(zw[e]), zb = hfhi(zw[e]);
        const float fa = lbv[2 * e] + (1.f - lbv[2 * e]) / (1.f + __expf(-za));
        const float fb = lbv[2 * e + 1] + (1.f - lbv[2 * e + 1]) / (1.f + __expf(-zb));
        kk[2 * e] = 1.f - fa;
        kk[2 * e + 1] = 1.f - fb;
        Lf[tau * 65 + kc + 2 * e] = __logf(fa);
        Lf[tau * 65 + kc + 2 * e + 1] = __logf(fb);
        Vt[(kc + 2 * e) * 72 + tau] = (u16)(vw[e] & 0xffffu);
        Vt[(kc + 2 * e + 1) * 72 + tau] = (u16)(vw[e] >> 16);
      }
    }
    __syncthreads();
    {
      const int k = tid & 63, sg = tid >> 6;
      float run = 0.f;
#pragma unroll
      for (int i = 0; i < 16; ++i) {
        float* ptr = &Lf[(sg * 16 + i) * 65 + k];
        run += *ptr;
        *ptr = run;
      }
      Seg[sg * 64 + k] = run;
    }
    __syncthreads();
    {
      const int sg = tau >> 4;
      unsigned qmw[8], kmw[8];
#pragma unroll
      for (int e = 0; e < 8; ++e) {
        float qq[2], km2[2];
#pragma unroll
        for (int u = 0; u < 2; ++u) {
          const int i = 2 * e + u, k = kc + i;
          const float s0 = Seg[k], s1 = Seg[64 + k], s2 = Seg[128 + k];
          const float off = (sg > 0 ? s0 : 0.f) + (sg > 1 ? s1 : 0.f) + (sg > 2 ? s2 : 0.f);
          const float bc = Lf[tau * 65 + k] + off;
          const float rr = Lf[31 * 65 + k] + s0;
          qq[u] = qv[i] * __expf(bc - rr);
          km2[u] = kk[i] * __expf(rr - bc);
          KmT[k * 72 + tau] = f2bf(km2[u]);
        }
        qmw[e] = pack2(qq[0], qq[1]);
        kmw[e] = pack2(km2[0], km2[1]);
      }
      *(uint4*)&Qm[tau * 72 + kc] = make_uint4(qmw[0], qmw[1], qmw[2], qmw[3]);
      *(uint4*)&Qm[tau * 72 + kc + 8] = make_uint4(qmw[4], qmw[5], qmw[6], qmw[7]);
      *(uint4*)&Km[tau * 72 + kc] = make_uint4(kmw[0], kmw[1], kmw[2], kmw[3]);
      *(uint4*)&Km[tau * 72 + kc + 8] = make_uint4(kmw[4], kmw[5], kmw[6], kmw[7]);
#pragma unroll
      for (int nt = 0; nt < 4; ++nt) {
        const int k = nt * 16 + r;
        const float er = __expf(Lf[31 * 65 + k] + Seg[k]);
#pragma unroll
        for (int j = 0; j < 4; ++j) St[(w * 16 + g * 4 + j) * 72 + k] = f2bf(Sacc[nt][j] * er);
      }
    }
    __syncthreads();
    bf16x8 aq[2];
#pragma unroll
    for (int ks = 0; ks < 2; ++ks) aq[ks] = *(const bf16x8*)&Qm[(w * 16 + r) * 72 + ks * 32 + g * 8];
    f32x4 oacc[4];
#pragma unroll
    for (int nt = 0; nt < 4; ++nt) {
      f32x4 a = zero4();
#pragma unroll
      for (int ks = 0; ks < 2; ++ks) {
        const bf16x8 bk = *(const bf16x8*)&Km[(nt * 16 + r) * 72 + ks * 32 + g * 8];
        a = MFMA(aq[ks], bk, a);
      }
#pragma unroll
      for (int j = 0; j < 4; ++j) {
        const bool keep = (nt * 16 + r) <= (w * 16 + g * 4 + j);
        const float v = keep ? a[j] : 0.f;
        Att[(w * 16 + g * 4 + j) * 72 + nt * 16 + r] = f2bf(v);
      }
    }
#pragma unroll
    for (int nt = 0; nt < 4; ++nt) {
      f32x4 a = zero4();
#pragma unroll
      for (int ks = 0; ks < 2; ++ks) {
        const bf16x8 bs = *(const bf16x8*)&St[(nt * 16 + r) * 72 + ks * 32 + g * 8];
        a = MFMA(aq[ks], bs, a);
      }
      oacc[nt] = a;
    }
    __syncthreads();
    bf16x8 aa[2], av[2];
#pragma unroll
    for (int ks = 0; ks < 2; ++ks) {
      aa[ks] = *(const bf16x8*)&Att[(w * 16 + r) * 72 + ks * 32 + g * 8];
      av[ks] = *(const bf16x8*)&Vt[(w * 16 + r) * 72 + ks * 32 + g * 8];
    }
#pragma unroll
    for (int nt = 0; nt < 4; ++nt) {
#pragma unroll
      for (int ks = 0; ks < 2; ++ks) {
        const bf16x8 bv = *(const bf16x8*)&Vt[(nt * 16 + r) * 72 + ks * 32 + g * 8];
        oacc[nt] = MFMA(aa[ks], bv, oacc[nt]);
      }
#pragma unroll
      for (int j = 0; j < 4; ++j) {
        const int t = w * 16 + g * 4 + j;
        const int tk = base + (dir ? 63 - t : t);
        Og[(size_t)tk * 64 + nt * 16 + r] = oacc[nt][j];
      }
    }
#pragma unroll
    for (int nt = 0; nt < 4; ++nt) {
      f32x4 u = zero4();
#pragma unroll
      for (int ks = 0; ks < 2; ++ks) {
        const bf16x8 bk = *(const bf16x8*)&KmT[(nt * 16 + r) * 72 + ks * 32 + g * 8];
        u = MFMA(av[ks], bk, u);
      }
      const int k = nt * 16 + r;
      const float s0 = Seg[k], s1 = Seg[64 + k], s2 = Seg[128 + k], s3 = Seg[192 + k];
      const float blast = s0 + s1 + s2 + s3;
      const float rk = Lf[31 * 65 + k] + s0;
      const float e1 = __expf(blast), e2 = __expf(blast - rk);
#pragma unroll
      for (int j = 0; j < 4; ++j) Sacc[nt][j] = e1 * Sacc[nt][j] + e2 * u[j];
    }
    __syncthreads();
  }
  __threadfence();
  __syncthreads();
  {
    const float* of = p.OF + (size_t)(b * 4 + h) * T * 64;
    const float* ob = p.OB + (size_t)(b * 4 + h) * T * 64;
    const float* ng = p.hg_norm_g + l * 64;
    const int ntok = (l == 0) ? T : SEQ;
    for (int idx0 = tid512; idx0 < ntok * 16; idx0 += 4 * NT) {
      float4 a4[4], b4[4];
      uint2 g4[4];
#pragma unroll
      for (int u = 0; u < 4; ++u) {
        const int idx = idx0 + u * NT;
        const int tok = idx >> 4, dv4 = idx & 15;
        const int row = tok < 2048 ? b * 2048 + tok : MLAT + b * 256 + (tok - 2048);
        a4[u] = *(const float4*)(of + (size_t)tok * 64 + dv4 * 4);
        b4[u] = *(const float4*)(ob + (size_t)tok * 64 + dv4 * 4);
        g4[u] = *(const uint2*)(p.G + (size_t)row * 1024 + h * 64 + dv4 * 4);
      }
#pragma unroll
      for (int u = 0; u < 4; ++u) {
        const int idx = idx0 + u * NT;
        const int tok = idx >> 4, dv4 = idx & 15;
        const float o0 = a4[u].x + b4[u].x, o1 = a4[u].y + b4[u].y, o2 = a4[u].z + b4[u].z, o3 = a4[u].w + b4[u].w;
        float ss = o0 * o0 + o1 * o1 + o2 * o2 + o3 * o3;
        ss += __shfl_xor(ss, 1);
        ss += __shfl_xor(ss, 2);
        ss += __shfl_xor(ss, 4);
        ss += __shfl_xor(ss, 8);
        const float rinv = rsqrtf(ss * (1.f / 64.f) + 1e-6f);
        const int row = tok < 2048 ? b * 2048 + tok : MLAT + b * 256 + (tok - 2048);
        const int col = h * 64 + dv4 * 4;
        const float4 n4 = *(const float4*)(ng + dv4 * 4);
        uint2 o;
        o.x = pack2(o0 * rinv * n4.x * bflo(g4[u].x), o1 * rinv * n4.y * bfhi(g4[u].x));
        o.y = pack2(o2 * rinv * n4.z * bflo(g4[u].y), o3 * rinv * n4.w * bfhi(g4[u].y));
        *(uint2*)(p.H + (size_t)row * 1024 + col) = o;
      }
    }
  }
  __syncthreads();
}

DI void phase_mix(const P& p, int l, int rep, char* lds) {
  __shared__ int s_item;
  const int nitems = 64 + 512 + 256 + 256 + (l == 0 ? 128 : 0);
  const float lam_init = (l == 0) ? 0.2f : (0.8f - 0.6f * 0.7408182206817179f);
  const float* dl = p.df_lam + l * 128;
  float d01 = 0.f, d23 = 0.f;
  for (int i = 0; i < 32; ++i) {
    d01 += dl[i] * dl[32 + i];
    d23 += dl[64 + i] * dl[96 + i];
  }
  const float lam = expf(d01) - expf(d23) + lam_init;
  const float* subln = p.df_subln + l * 64;
  const float cB = 0.125f * LOG2E, cC = 0.17677669529663687f * LOG2E;
  while (true) {
    if (tidx() == 0) s_item = atomicAdd(&p.ctr[l + 2 * rep], 1);
    __syncthreads();
    int it = __builtin_amdgcn_readfirstlane(s_item);
    __syncthreads();
    if (it >= nitems) break;
    if (it < 64) {
      hgrn_unit(p, l, it, lds);
      continue;
    }
    it -= 64;
    int mode, b, hq, qb, sq0, sq1, sk, sv, qtok0, ka0, na, kb0 = 2048, nb = 0, yrow0, ycol0;
    bool window = false, has_sink = false, isctx = false;
    int kind;
    if (it < 512) { kind = 0; b = it >> 5; hq = (it >> 3) & 3; qb = it & 7; }
    else if (it < 768) { it -= 512; kind = 1; b = it >> 4; hq = (it >> 3) & 1; qb = it & 7; }
    else if (it < 1024) { it -= 768; kind = 2; b = it >> 4; hq = (it >> 3) & 1; qb = it & 7; }
    else if (it < 1088) { it -= 1024; kind = 0; isctx = true; b = it >> 2; hq = it & 3; qb = 0; }
    else if (it < 1120) { it -= 1088; kind = 1; isctx = true; b = it >> 1; hq = it & 1; qb = 0; }
    else { it -= 1120; kind = 2; isctx = true; b = it >> 1; hq = it & 1; qb = 0; }
    if (kind == 0) { mode = 1; sq0 = 24 + hq; sq1 = sq0; sk = 28 + hq; sv = 32 + hq; ycol0 = 512 + hq * 64; }
    else if (kind == 1) { mode = 0; sq0 = 16 + hq * 2; sq1 = sq0 + 1; sk = 20 + hq; sv = 22 + hq; ycol0 = 256 + hq * 128; }
    else { mode = 0; sq0 = 36 + hq * 2; sq1 = sq0 + 1; sk = 40 + hq; sv = 42 + hq; ycol0 = 768 + hq * 128; has_sink = true; }
    if (isctx) {
      qtok0 = 2048; ka0 = 2048; na = 4; yrow0 = MLAT + b * 256;
    } else {
      qtok0 = qb * 256; yrow0 = b * 2048 + qb * 256;
      if (kind == 2) {
        window = true;
        ka0 = qtok0 - 128 < 0 ? 0 : qtok0 - 128;
        const int ka1 = qtok0 + 384 > 2048 ? 2048 : qtok0 + 384;
        na = (ka1 - ka0) >> 6; nb = 4;
      } else { ka0 = 0; na = 36; }
    }
    float sk0 = 0.f, sk1 = 0.f;
    if (has_sink) { sk0 = p.wn_sink[l * 4 + hq * 2] * LOG2E; sk1 = p.wn_sink[l * 4 + hq * 2 + 1] * LOG2E; }
    if (mode == 1)
      attn_item<1>(p, slab_ptr(p, sq0, b), slab_ptr(p, sq1, b), slab_ptr(p, sk, b), slab_ptr(p, sv, b), qtok0, ka0, na, kb0, nb, window,
                   cC, has_sink, sk0, sk1, yrow0, ycol0, lam, subln, 1.f - lam_init, lds);
    else
      attn_item<0>(p, slab_ptr(p, sq0, b), slab_ptr(p, sq1, b), slab_ptr(p, sk, b), slab_ptr(p, sv, b), qtok0, ka0, na, kb0, nb, window,
                   cB, has_sink, sk0, sk1, yrow0, ycol0, lam, subln, 1.f, lds);
  }
}

DI void phase_ln(const P& p, int l) {
  const int tid = tidx(); const int lane = tid & 63, w = tid >> 6;
  const int nrows = (l == 0) ? MALL : MLAT;
  const float* Zb = (const float*)p.slab;
  const float* lg = p.ln_g + l * 1024;
  const float* lb = p.ln_b + l * 1024;
  const int gw = blockIdx.x * 8 + w, nw = gridDim.x * 8;
  const int per = (nrows + nw - 1) / nw;
  const int r0 = gw * per, r1 = (r0 + per < nrows) ? r0 + per : nrows;
  float4 g4[4], b4[4];
#pragma unroll
  for (int i = 0; i < 4; ++i) {
    g4[i] = *(const float4*)(lg + i * 256 + lane * 4);
    b4[i] = *(const float4*)(lb + i * 256 + lane * 4);
  }
  for (int row = r0; row < r1; row += 2) {
    const bool two = row + 1 < r1;
    const int rowb = two ? row + 1 : row;
    float4 v[2][4];
#pragma unroll
    for (int i = 0; i < 4; ++i) {
      v[0][i] = *(const float4*)(Zb + (size_t)row * 1024 + i * 256 + lane * 4);
      v[1][i] = *(const float4*)(Zb + (size_t)rowb * 1024 + i * 256 + lane * 4);
    }
#pragma unroll
    for (int h = 0; h < 2; ++h) {
      if (h && !two) break;
      const int rr = h ? rowb : row;
      float s = 0.f;
#pragma unroll
      for (int i = 0; i < 4; ++i) s += (v[h][i].x + v[h][i].y) + (v[h][i].z + v[h][i].w);
#pragma unroll
      for (int o = 32; o >= 1; o >>= 1) s += __shfl_xor(s, o);
      const float mean = s * (1.f / 1024.f);
      float q = 0.f;
#pragma unroll
      for (int i = 0; i < 4; ++i) {
        v[h][i].x -= mean; v[h][i].y -= mean; v[h][i].z -= mean; v[h][i].w -= mean;
        q += (v[h][i].x * v[h][i].x + v[h][i].y * v[h][i].y) + (v[h][i].z * v[h][i].z + v[h][i].w * v[h][i].w);
      }
#pragma unroll
      for (int o = 32; o >= 1; o >>= 1) q += __shfl_xor(q, o);
      const float rstd = rsqrtf(q * (1.f / 1024.f) + 1e-5f);
      const int mr = rr < MLAT ? (rr >> 11) : 16;
      const float* md = p.mod + (size_t)(1 * 17 + mr) * 3072;
#pragma unroll
      for (int i = 0; i < 4; ++i) {
        const int col = i * 256 + lane * 4;
        float4 y;
        y.x = v[h][i].x * rstd * g4[i].x + b4[i].x;
        y.y = v[h][i].y * rstd * g4[i].y + b4[i].y;
        y.z = v[h][i].z * rstd * g4[i].z + b4[i].z;
        y.w = v[h][i].w * rstd * g4[i].w + b4[i].w;
        if (l == 1 || rr < MLAT) *(float4*)(p.out + (size_t)rr * 1024 + col) = y;
        if (l == 0) {
          const float4 sh = *(const float4*)(md + col), sc = *(const float4*)(md + 1024 + col);
          uint2 o;
          o.x = pack2(y.x * (1.f + sc.x) + sh.x, y.y * (1.f + sc.y) + sh.y);
          o.y = pack2(y.z * (1.f + sc.z) + sh.z, y.w * (1.f + sc.w) + sh.w);
          *(uint2*)(p.H + (size_t)rr * 1024 + col) = o;
        }
      }
    }
  }
}


#define XB_TMO      128
#define XB_XCNT(j)  (256  + 64 * (j))
#define XB_XSUB(j)  (1280 + 64 * (j))
#define XB_XGEN(j)  (2304 + 64 * (j))
#define XB_TOP      3328
#define XB_TOPGEN   3392
#define XCD_BAR_WORDS 3456
#define XB_SPIN_CAP (1u << 18)
#define LAS __attribute__((address_space(3)))

__device__ __forceinline__ unsigned xb_ld(unsigned* p)              { return __hip_atomic_load(p, __ATOMIC_RELAXED, __HIP_MEMORY_SCOPE_AGENT); }
__device__ __forceinline__ unsigned xb_add(unsigned* p, unsigned v) { return __hip_atomic_fetch_add(p, v, __ATOMIC_RELAXED, __HIP_MEMORY_SCOPE_AGENT); }
__device__ __forceinline__ unsigned xb_xcc_id() { return (unsigned)__builtin_amdgcn_s_getreg((3 << 11) | 20) & 0xFu; }
#define XB_SPIN(cond, bar) do { unsigned _sp = 0; while (cond) { __builtin_amdgcn_s_sleep(1); \
    if ((++_sp & 255u) == 0u) { if (xb_ld(&(bar)[XB_TMO])) break; if (_sp > XB_SPIN_CAP) { atomicAdd(&(bar)[XB_TMO], 1u); break; } } } } while (0)

struct XcdBarrier {
    unsigned* bar; unsigned x;
    volatile LAS unsigned* st;
};

__device__ __forceinline__ XcdBarrier xcd_barrier_post(unsigned* bar, volatile LAS unsigned* st) {
    XcdBarrier b; b.bar = bar; b.x = xb_xcc_id(); b.st = st;
    if (threadIdx.x == 0) (void)xb_add(&bar[XB_XCNT(b.x)], 1u);
    return b;
}
__device__ __forceinline__ void xcd_barrier_complete(unsigned* bar, unsigned x, unsigned& nloc, unsigned& nx) {
    const unsigned G = gridDim.x * gridDim.y * gridDim.z;
    unsigned sum, cnt, mine, sp = 0u;
    for (;;) {
        sum = 0u; cnt = 0u; mine = 0u;
#pragma unroll
        for (unsigned j = 0; j < 16; ++j) { const unsigned c = xb_ld(&bar[XB_XCNT(j)]); sum += c; cnt += (c > 0u) ? 1u : 0u; mine = (j == x) ? c : mine; }
        if (sum == G) break;
        __builtin_amdgcn_s_sleep(1);
        if ((++sp & 255u) == 0u) { if (xb_ld(&bar[XB_TMO])) break; if (sp > XB_SPIN_CAP) { atomicAdd(&bar[XB_TMO], 1u); break; } }
    }
    nloc = mine > 0u ? mine : 1u; nx = cnt > 0u ? cnt : 1u;
}

__device__ __forceinline__ void xcd_barrier(const XcdBarrier& b) {
    asm volatile("s_waitcnt vmcnt(0)" ::: "memory");
    __syncthreads();
    if (threadIdx.x == 0) {
        unsigned* bar = b.bar;
        __builtin_amdgcn_s_waitcnt(0);
        unsigned nloc = b.st[0], nx = b.st[1];
        if (nloc == 0u) { xcd_barrier_complete(bar, b.x, nloc, nx); b.st[0] = nloc; b.st[1] = nx; }
        const unsigned old = xb_add(&bar[XB_XSUB(b.x)], 1u);
        const unsigned gen = old / nloc;
        if (old + 1u == (gen + 1u) * nloc) {
            __builtin_amdgcn_fence(__ATOMIC_RELEASE, "agent");
            asm volatile("s_waitcnt vmcnt(0)" ::: "memory");
            const unsigned og = xb_add(&bar[XB_TOP], 1u);
            const unsigned tg = og / nx;
            if (og + 1u == (tg + 1u) * nx) xb_add(&bar[XB_TOPGEN], 1u);
            else XB_SPIN(xb_ld(&bar[XB_TOPGEN]) == tg, bar);
            __builtin_amdgcn_fence(__ATOMIC_ACQUIRE, "agent");
            xb_add(&bar[XB_XGEN(b.x)], 1u);
            asm volatile("s_waitcnt vmcnt(0)" ::: "memory");
        } else {
            XB_SPIN(xb_ld(&bar[XB_XGEN(b.x)]) == gen, bar);
            __builtin_amdgcn_fence(__ATOMIC_ACQUIRE, "agent");
            asm volatile("s_waitcnt vmcnt(0)" ::: "memory");
        }
    }
    __syncthreads();
}


__global__ void __launch_bounds__(512, 2) mega(P p) {
  extern __shared__ __attribute__((aligned(16))) char lds[];
  __shared__ uint4 xb_words;
  if (threadIdx.x == 0) xb_words = make_uint4(0u, 0u, 0u, 0u);
  __syncthreads();
  const XcdBarrier xb = xcd_barrier_post(p.xbar, (volatile LAS unsigned*)&xb_words);
  for (int ph = p.pb; ph < p.pe; ++ph) {
    if (ph == 0) phase_prep(p, lds);
    else if (ph == 1) phase_h0(p);
    else {
      const int l = (ph - 2) >> 2, s = (ph - 2) & 3;
      if (s == 0) { for (int rr = 0; rr < REP_INPROJ; ++rr) { if (rr) cg::this_grid().sync(); phase_inproj(p, l, lds); } }
      else if (s == 1) { for (int rr = 0; rr < REP_MIX; ++rr) { if (rr) cg::this_grid().sync(); phase_mix(p, l, rr, lds); } }
      else if (s == 2) { for (int rr = 0; rr < REP_OUT; ++rr) { if (rr) cg::this_grid().sync(); phase_outproj(p, l, lds); } }
      else phase_ln(p, l);
    }
    if (ph + 1 < p.pe) {
      if (p.pe < 0) cg::this_grid().sync();
      xcd_barrier(xb);
    }
  }
}

extern "C" void kernel_launch(void* const* d_in, const int* in_sizes, int n_in, void* d_out, int out_size, void* d_ws,
                              size_t ws_size, hipStream_t stream) {
  static int grid_blocks = 0;
  if (!grid_blocks) {
    int dev = 0, cus = 0, per_cu = 0;
    hipGetDevice(&dev);
    hipDeviceGetAttribute(&cus, hipDeviceAttributeMultiprocessorCount, dev);
    hipFuncSetAttribute((const void*)mega, hipFuncAttributeMaxDynamicSharedMemorySize, LDS_BYTES);
    hipOccupancyMaxActiveBlocksPerMultiprocessor(&per_cu, (const void*)mega, NT, LDS_BYTES);
    per_cu = 1;
    grid_blocks = cus * per_cu;
  }
  P p{};
  p.x = (const float*)d_in[0]; p.c = (const float*)d_in[1]; p.ctx = (const float*)d_in[2]; p.c_ctx = (const float*)d_in[3];
  p.w_in = (const float*)d_in[4]; p.w_out = (const float*)d_in[5]; p.w_ada = (const float*)d_in[6]; p.b_ada = (const float*)d_in[7];
  p.ln_g = (const float*)d_in[8]; p.ln_b = (const float*)d_in[9]; p.lb_logits = (const float*)d_in[10];
  p.hg_norm_g = (const float*)d_in[11]; p.ga_qn = (const float*)d_in[12]; p.ga_kn = (const float*)d_in[13];
  p.df_lam = (const float*)d_in[14]; p.df_subln = (const float*)d_in[15]; p.wn_sink = (const float*)d_in[16];
  p.out = (float*)d_out;
  char* ws = (char*)d_ws;
  size_t off = 0;
  auto take = [&](size_t bytes) { char* q = ws + off; off += (bytes + 255) & ~(size_t)255; return q; };
  p.ctr = (int*)take(256);
  p.xbar = (unsigned*)take(16384);
  p.mod = (float*)take((size_t)2 * 17 * 3072 * 4);
  p.Wt = (u16*)take((size_t)2 * NIN * 1024 * 2);
  p.Wot = (u16*)take((size_t)2 * 1024 * 1024 * 2);
  p.H = (u16*)take((size_t)MALL * 1024 * 2);
  p.G = (u16*)take((size_t)MALL * 1024 * 2);
  p.OF = (float*)take((size_t)NB * 4 * T * 64 * 4);
  p.OB = (float*)take((size_t)NB * 4 * T * 64 * 4);
  p.slab = (u16*)take((size_t)44 * 16 * T * 64 * 2);
  if (off > ws_size) { fprintf(stderr, "workspace too small: need %zu have %zu\n", off, ws_size); return; }
  hipMemsetAsync(p.ctr, 0, 256 + 16384, stream);
#if MULTI_LAUNCH
  for (int ph = 0; ph < NPHASE; ++ph) {
    p.pb = ph; p.pe = ph + 1;
    hipLaunchKernelGGL(mega, dim3(grid_blocks), dim3(NT), LDS_BYTES, stream, p);
  }
#else
  p.pb = 0; p.pe = NPHASE;
  void* args[] = {&p};
  hipError_t e = hipLaunchCooperativeKernel((const void*)mega, dim3(grid_blocks), dim3(NT), args, LDS_BYTES, stream);
  if (e != hipSuccess) fprintf(stderr, "cooperative launch failed: %s (grid %d)\n", hipGetErrorString(e), grid_blocks);
#endif
}
```

```cpp
#include <hip/hip_runtime.h>
#include <hip/hip_cooperative_groups.h>
#include <cstdio>
namespace cg = cooperative_groups;

typedef unsigned short u16;
typedef __attribute__((ext_vector_type(8))) short bf16x8;
typedef __attribute__((ext_vector_type(4))) float f32x4;
#define DI __device__ __forceinline__
#define MFMA(a, b, c) __builtin_amdgcn_mfma_f32_16x16x32_bf16((a), (b), (c), 0, 0, 0)

#ifndef REP_INPROJ
#define REP_INPROJ 1
#endif
#ifndef REP_MIX
#define REP_MIX 1
#endif
#ifndef REP_OUT
#define REP_OUT 1
#endif
#ifndef MULTI_LAUNCH
#define MULTI_LAUNCH 0
#endif

constexpr int NB = 16, SEQ = 2048, LC = 256, T = 2304, DM = 1024, NIN = 3840;
constexpr int MLAT = NB * SEQ;
constexpr int MALL = MLAT + NB * LC;
constexpr int LDS_BYTES = 147456;
constexpr int NT = 512;
constexpr int NPHASE = 10;
constexpr float LOG2E = 1.4426950408889634f;

struct P {
  const float *x, *c, *ctx, *c_ctx, *w_in, *w_out, *w_ada, *b_ada, *ln_g, *ln_b, *lb_logits, *hg_norm_g, *ga_qn, *ga_kn,
      *df_lam, *df_subln, *wn_sink;
  float* out;
  u16 *Wt, *Wot, *H, *slab, *G;
  float *mod, *OF, *OB;
  int* ctr;
  unsigned* xbar;
  int pb, pe;
};

typedef __bf16 bf2_t __attribute__((ext_vector_type(2)));
typedef float f2_t __attribute__((ext_vector_type(2)));
DI unsigned pack2(float a, float b) {
  f2_t v = {a, b};
  return __builtin_bit_cast(unsigned, __builtin_convertvector(v, bf2_t));
}
DI u16 f2bf(float x) { return (u16)pack2(x, 0.f); }
DI float bflo(unsigned w) { return __uint_as_float(w << 16); }
DI float bfhi(unsigned w) { return __uint_as_float(w & 0xffff0000u); }
DI float hflo(unsigned w) { return (float)__builtin_bit_cast(_Float16, (u16)(w & 0xffffu)); }
DI float hfhi(unsigned w) { return (float)__builtin_bit_cast(_Float16, (u16)(w >> 16)); }
DI u16 f2h(float x) { return __builtin_bit_cast(u16, (_Float16)x); }
DI float silu(float v) { return v * __builtin_amdgcn_rcpf(1.f + __builtin_amdgcn_exp2f(-1.4426950408889634f * v)); }
DI void sincos_rev(float ang, float& s, float& c) {
  float rev = ang * 0.15915494309189535f;
  rev -= rintf(rev);
  s = __builtin_amdgcn_sinf(rev);
  c = __builtin_amdgcn_cosf(rev);
}
DI u16* slab_ptr(const P& p, int sidx, int b) { return p.slab + (size_t)(sidx * 16 + b) * (size_t)(T * 64); }
DI int tidx() { int t = threadIdx.x; asm volatile("" : "+v"(t)); return t; }
DI f32x4 zero4() { f32x4 z = {0.f, 0.f, 0.f, 0.f}; return z; }

DI void mod_item(const P& p, int item, char* lds) {
  const int tid = tidx(), lane = tid & 63, w = tid >> 6;
  const int l = item / 96, cb = item % 96;
  float* sv = (float*)lds;
  for (int i = tid; i < 17 * 1024; i += NT) {
    int r = i >> 10, k = i & 1023;
    float v = r < 16 ? p.c[r * 1024 + k] : p.c_ctx[k];
    sv[i] = silu(v);
  }
  __syncthreads();
  const int c = tid & 31, ks = tid >> 5, n = cb * 32 + c;
  const float* W = p.w_ada + (size_t)l * 1024 * 3072 + n;
  float acc[17];
#pragma unroll
  for (int r = 0; r < 17; ++r) acc[r] = 0.f;
  for (int k = ks * 64; k < ks * 64 + 64; k += 8) {
    float wv[8];
#pragma unroll
    for (int u = 0; u < 8; ++u) wv[u] = W[(size_t)(k + u) * 3072];
#pragma unroll
    for (int u = 0; u < 8; ++u)
#pragma unroll
      for (int r = 0; r < 17; ++r) acc[r] += sv[r * 1024 + k + u] * wv[u];
  }
#pragma unroll
  for (int r = 0; r < 17; ++r) acc[r] += __shfl_xor(acc[r], 32);
  __syncthreads();
  float* red = (float*)lds;
  if (lane < 32) {
#pragma unroll
    for (int r = 0; r < 17; ++r) red[(w * 17 + r) * 32 + c] = acc[r];
  }
  __syncthreads();
  for (int i = tid; i < 17 * 32; i += NT) {
    int r = i >> 5, cc = i & 31;
    float sum = 0.f;
#pragma unroll
    for (int ww = 0; ww < 8; ++ww) sum += red[(ww * 17 + r) * 32 + cc];
    int nn = cb * 32 + cc;
    p.mod[(size_t)(l * 17 + r) * 3072 + nn] = sum + p.b_ada[l * 3072 + nn];
  }
  __syncthreads();
}

DI void transpose_item(const float* __restrict__ W, u16* __restrict__ Wt, int N, int kt, int nt, char* lds) {
  const int tid = tidx();
  u16* tile = (u16*)lds;
  if (tid < 256) {
    const int r = tid >> 2, cs = (tid & 3) * 16;
    const float* src = W + (size_t)(kt * 64 + r) * N + nt * 64 + cs;
#pragma unroll
    for (int q = 0; q < 4; ++q) {
      float4 v = *(const float4*)(src + q * 4);
      tile[(cs + q * 4 + 0) * 72 + r] = f2bf(v.x);
      tile[(cs + q * 4 + 1) * 72 + r] = f2bf(v.y);
      tile[(cs + q * 4 + 2) * 72 + r] = f2bf(v.z);
      tile[(cs + q * 4 + 3) * 72 + r] = f2bf(v.w);
    }
  }
  __syncthreads();
  if (tid < 256) {
    const int n = tid >> 2, ks = (tid & 3) * 16;
    uint4 a = *(const uint4*)&tile[n * 72 + ks];
    uint4 b = *(const uint4*)&tile[n * 72 + ks + 8];
    u16* dst = Wt + (size_t)(nt * 64 + n) * 1024 + kt * 64 + ks;
    *(uint4*)dst = a;
    *(uint4*)(dst + 8) = b;
  }
  __syncthreads();
}

DI void phase_prep(const P& p, char* lds) {
  for (int it = blockIdx.x; it < 192 + 1920 + 512; it += gridDim.x) {
    if (it < 192) {
      mod_item(p, it, lds);
    } else if (it < 192 + 1920) {
      int t = it - 192;
      int l = t / 960, rem = t % 960;
      int kt = rem / 60, nt = rem % 60;
      transpose_item(p.w_in + (size_t)l * 1024 * NIN, p.Wt + (size_t)l * NIN * 1024, NIN, kt, nt, lds);
    } else {
      int t = it - 192 - 1920;
      int l = t >> 8, rem = t & 255;
      int kt = rem >> 4, nt = rem & 15;
      transpose_item(p.w_out + (size_t)l * 1024 * 1024, p.Wot + (size_t)l * 1024 * 1024, 1024, kt, nt, lds);
    }
  }
}

DI void phase_h0(const P& p) {
  const int tid = tidx(), lane = tid & 63, w = tid >> 6;
  const int gw = blockIdx.x * 8 + w, nw = gridDim.x * 8;
  const int per = (MALL + nw - 1) / nw;
  const int r0 = gw * per, r1 = (r0 + per < MALL) ? r0 + per : MALL;
  int cur_mr = -1;
  float4 sh[4], sc[4];
  for (int row = r0; row < r1; row += 2) {
    const bool two = row + 1 < r1;
    const int rowb = two ? row + 1 : row;
    const float* sa = row < MLAT ? p.x + (size_t)row * 1024 : p.ctx + (size_t)(row - MLAT) * 1024;
    const float* sb = rowb < MLAT ? p.x + (size_t)rowb * 1024 : p.ctx + (size_t)(rowb - MLAT) * 1024;
    float4 va[4], vb[4];
#pragma unroll
    for (int i = 0; i < 4; ++i) {
      va[i] = *(const float4*)(sa + i * 256 + lane * 4);
      vb[i] = *(const float4*)(sb + i * 256 + lane * 4);
    }
#pragma unroll
    for (int half = 0; half < 2; ++half) {
      const int rr = half ? rowb : row;
      if (half && !two) break;
      const int mr = rr < MLAT ? (rr >> 11) : 16;
      if (mr != cur_mr) {
        cur_mr = mr;
        const float* md = p.mod + (size_t)mr * 3072;
#pragma unroll
        for (int i = 0; i < 4; ++i) {
          sh[i] = *(const float4*)(md + i * 256 + lane * 4);
          sc[i] = *(const float4*)(md + 1024 + i * 256 + lane * 4);
        }
      }
#pragma unroll
      for (int i = 0; i < 4; ++i) {
        const float4 v = half ? vb[i] : va[i];
        uint2 o;
        o.x = pack2(v.x * (1.f + sc[i].x) + sh[i].x, v.y * (1.f + sc[i].y) + sh[i].y);
        o.y = pack2(v.z * (1.f + sc[i].z) + sh[i].z, v.w * (1.f + sc[i].w) + sh[i].w);
        *(uint2*)(p.H + (size_t)rr * 1024 + i * 256 + lane * 4) = o;
      }
    }
  }
}

template <int EPI>
DI bool tile_coords(int j, int mpx, int& m0, int& n0) {
  const int x = blockIdx.x & 7, s = blockIdx.x >> 3, ns = gridDim.x >> 3;
  const int q = s + ns * j;
  if constexpr (EPI == 0) {
    if (q >= mpx * 15) return false;
    const int panel = q / 90, i = q % 90;
    const int nt = i / 6, mi = i % 6;
    m0 = (x * mpx + panel * 6 + mi) * 256;
    n0 = nt * 256;
  } else {
    if (q >= mpx * 4) return false;
    m0 = (x * mpx + (q >> 2)) * 256;
    n0 = (q & 3) * 256;
  }
  return true;
}

template <int EPI>
DI void gemm_phase(const P& p, int l, const u16* __restrict__ A, const u16* __restrict__ Bt, int mpx, char* lds) {
  const int tid = tidx();
  int t = 0;
  int m0, n0;
  if (!tile_coords<EPI>(t, mpx, m0, n0)) return;
  const unsigned voffb = (unsigned)(((tid >> 3) * 1024 + (tid & 7) * 8) * 2);
  const u16* Ag = A + (size_t)m0 * 1024;
  const u16* Bg = Bt + (size_t)n0 * 1024;
  uint4 ra0, ra1, ra2, ra3, rb0, rb1, rb2, rb3;
#define GLOAD(AP, BP, k0)                                                       \
  ra0 = *(const uint4*)((const char*)((AP) + 0 * 64 * 1024 + (k0)) + voffb);   \
  ra1 = *(const uint4*)((const char*)((AP) + 1 * 64 * 1024 + (k0)) + voffb);   \
  ra2 = *(const uint4*)((const char*)((AP) + 2 * 64 * 1024 + (k0)) + voffb);   \
  ra3 = *(const uint4*)((const char*)((AP) + 3 * 64 * 1024 + (k0)) + voffb);   \
  rb0 = *(const uint4*)((const char*)((BP) + 0 * 64 * 1024 + (k0)) + voffb);   \
  rb1 = *(const uint4*)((const char*)((BP) + 1 * 64 * 1024 + (k0)) + voffb);   \
  rb2 = *(const uint4*)((const char*)((BP) + 2 * 64 * 1024 + (k0)) + voffb);   \
  rb3 = *(const uint4*)((const char*)((BP) + 3 * 64 * 1024 + (k0)) + voffb);
#define GSTORE(AS, BS)                       \
  *(uint4*)&(AS)[lw + 0 * 64 * 64] = ra0;    \
  *(uint4*)&(AS)[lw + 1 * 64 * 64] = ra1;    \
  *(uint4*)&(AS)[lw + 2 * 64 * 64] = ra2;    \
  *(uint4*)&(AS)[lw + 3 * 64 * 64] = ra3;    \
  *(uint4*)&(BS)[lw + 0 * 64 * 64] = rb0;    \
  *(uint4*)&(BS)[lw + 1 * 64 * 64] = rb1;    \
  *(uint4*)&(BS)[lw + 2 * 64 * 64] = rb2;    \
  *(uint4*)&(BS)[lw + 3 * 64 * 64] = rb3;
#define GCOMPUTE_KS(AS, BS, ks)                                                                                   \
  {                                                                                                               \
    bf16x8 bfr[4];                                                                                                \
    _Pragma("unroll") for (int ni = 0; ni < 4; ++ni) bfr[ni] = *(const bf16x8*)&(BS)[(wn * 64 + ni * 16 + r) * 64 + ((((ks) * 4 + g) ^ (r & 7)) * 8)]; \
    _Pragma("unroll") for (int mh = 0; mh < 2; ++mh) {                                                            \
      bf16x8 af[4];                                                                                               \
      _Pragma("unroll") for (int mi = 0; mi < 4; ++mi) af[mi] = *(const bf16x8*)&(AS)[(wm * 128 + (mh * 4 + mi) * 16 + r) * 64 + ((((ks) * 4 + g) ^ (r & 7)) * 8)];  \
      _Pragma("unroll") for (int mi = 0; mi < 4; ++mi)                                                            \
        _Pragma("unroll") for (int ni = 0; ni < 4; ++ni) acc[mh * 4 + mi][ni] = MFMA(af[mi], bfr[ni], acc[mh * 4 + mi][ni]);  \
    }                                                                                                             \
  }
#define GCOMPUTE(AS, BS) GCOMPUTE_KS(AS, BS, 0) GCOMPUTE_KS(AS, BS, 1)
  GLOAD(Ag, Bg, 0)
  u16* As0 = (u16*)lds;
  u16* Bs0 = As0 + 256 * 64;
  u16* As1 = Bs0 + 256 * 64;
  u16* Bs1 = As1 + 256 * 64;
  const int lw = (tid >> 3) * 64 + (((tid & 7) ^ ((tid >> 3) & 7)) * 8);
  GSTORE(As0, Bs0)
  while (true) {
  const int tn = t + 1;
  int m1 = 0, n1 = 0;
  const bool has_next = tile_coords<EPI>(tn, mpx, m1, n1);
  const u16* Agn = A + (size_t)m1 * 1024;
  const u16* Bgn = Bt + (size_t)n1 * 1024;
  f32x4 acc[8][4];
#pragma unroll
  for (int i = 0; i < 8; ++i)
#pragma unroll
    for (int j = 0; j < 4; ++j) acc[i][j] = zero4();
  {
  const int lane = tid & 63, w = tid >> 6, r = lane & 15, g = lane >> 4, wm = w >> 2, wn = w & 3;
  __syncthreads();
  GLOAD(Ag, Bg, 64)
  __builtin_amdgcn_sched_barrier(0);
  GCOMPUTE_KS(As0, Bs0, 0)
  __builtin_amdgcn_sched_barrier(0);
  GSTORE(As1, Bs1)
  GLOAD(Ag, Bg, 128)
  __builtin_amdgcn_sched_barrier(0);
  GCOMPUTE_KS(As0, Bs0, 1)
  __builtin_amdgcn_sched_barrier(0);
#pragma unroll 1
  for (int kk = 1; kk < 15; kk += 2) {
    __syncthreads();
    GSTORE(As0, Bs0)
    GLOAD(Ag, Bg, (kk + 2) * 64)
    __builtin_amdgcn_sched_barrier(0);
    GCOMPUTE(As1, Bs1)
    __builtin_amdgcn_sched_barrier(0);
    __syncthreads();
    GSTORE(As1, Bs1)
    {
      const bool in_tile = kk + 3 < 16;
      const u16* pa = in_tile ? Ag : Agn;
      const u16* pb = in_tile ? Bg : Bgn;
      const int k0 = in_tile ? (kk + 3) * 64 : 0;
      GLOAD(pa, pb, k0)
    }
    __builtin_amdgcn_sched_barrier(0);
    GCOMPUTE(As0, Bs0)
    __builtin_amdgcn_sched_barrier(0);
  }
  __syncthreads();
  __builtin_amdgcn_sched_barrier(0);
  GCOMPUTE(As1, Bs1)
  __builtin_amdgcn_sched_barrier(0);
  }
  __syncthreads();
  GSTORE(As0, Bs0)
  const int tid_e = tidx();
  const int lane = tid_e & 63, w = tid_e >> 6, r = lane & 15, g = lane >> 4, wm = w >> 2, wn = w & 3;
  if constexpr (EPI == 1) {
    const float alpha = 1.4142135623730951f;
    float* Cw = (float*)(lds + 65536) + w * (16 * 68);
    const int mr = m0 < MLAT ? (m0 >> 11) : 16;
    const int colw = n0 + wn * 64;
    const float* gate = p.mod + (size_t)(l * 17 + mr) * 3072 + 2048 + colw;
    const float* xr = ((l == 0) ? (m0 < MLAT ? p.x + (size_t)m0 * 1024 : p.ctx + (size_t)(m0 - MLAT) * 1024)
                                : p.out + (size_t)m0 * 1024) + (size_t)(wm * 128) * 1024 + colw;
    float* Z = (float*)p.slab + (size_t)(m0 + wm * 128) * 1024 + colw;
    const int c4 = (lane & 15) * 4, rr0 = lane >> 4;
    const float4 gt = *(const float4*)(gate + c4);
    float4 xn[4];
#pragma unroll
    for (int i = 0; i < 4; ++i) xn[i] = *(const float4*)(xr + (size_t)(rr0 + 4 * i) * 1024 + c4);
#pragma unroll
    for (int mi = 0; mi < 8; ++mi) {
      float4 xv[4];
#pragma unroll
      for (int i = 0; i < 4; ++i) xv[i] = xn[i];
      if (mi < 7) {
#pragma unroll
        for (int i = 0; i < 4; ++i) xn[i] = *(const float4*)(xr + (size_t)((mi + 1) * 16 + rr0 + 4 * i) * 1024 + c4);
      }
#pragma unroll
      for (int ni = 0; ni < 4; ++ni)
#pragma unroll
        for (int j = 0; j < 4; ++j) Cw[(g * 4 + j) * 68 + ni * 16 + r] = acc[mi][ni][j];
      __builtin_amdgcn_fence(__ATOMIC_RELEASE, "wavefront");
#pragma unroll
      for (int i = 0; i < 4; ++i) {
        const int row = rr0 + 4 * i;
        const float4 a = *(const float4*)&Cw[row * 68 + c4];
        float4 z;
        z.x = alpha * xv[i].x + gt.x * a.x;
        z.y = alpha * xv[i].y + gt.y * a.y;
        z.z = alpha * xv[i].z + gt.z * a.z;
        z.w = alpha * xv[i].w + gt.w * a.w;
        *(float4*)(Z + (size_t)(mi * 16 + row) * 1024 + c4) = z;
      }
      __builtin_amdgcn_fence(__ATOMIC_RELEASE, "wavefront");
    }
  } else {
    const int cb = n0 + wn * 64;
    const bool isctx = m0 >= MLAT;
    const int b = isctx ? ((m0 - MLAT) >> 8) : (m0 >> 11);
    const int tokw = (isctx ? 2048 + ((m0 - MLAT) & 255) : (m0 & 2047)) + wm * 128;
    u16* Tl = (u16*)(lds + 65536) + w * (64 * 72);
    int kind = 0;
    int tr = 0;
    bool donorm = false;
    if (cb >= 2816) { kind = 2; tr = 1; }
    else if (cb < 256) tr = 1;
    else if (cb < 512) tr = 0;
    else if (cb < 1024) tr = 2;
    else if (cb < 1408) { tr = 3; donorm = true; }
    else if (cb < 1536) kind = 1;
    else if (cb < 2048) tr = isctx ? 0 : 4;
    else if (cb < 2304) kind = 1;
    else if (cb < 2688) tr = isctx ? 0 : 3;
    else kind = 1;
    const float* gw = (cb < 1280 ? p.ga_qn : p.ga_kn) + l * 64;
    float gv0 = 1.f, gv1 = 1.f, gv2 = 1.f, gv3 = 1.f;
    if (donorm) { gv0 = gw[r]; gv1 = gw[16 + r]; gv2 = gw[32 + r]; gv3 = gw[48 + r]; }
    const bool dorope = (tr == 3) && !isctx;
    const float invf64 = exp2f(-13.287712379549449f * (float)r * (1.f / 16.f));
    const float invf32 = exp2f(-13.287712379549449f * (float)(r & 7) * (1.f / 8.f));
    const bool lo8 = r < 8;
    u16* dst;
    size_t rstride;
    if (kind == 2) {
      dst = p.G + (size_t)(m0 + wm * 128) * 1024 + (cb - 2816);
      rstride = 1024;
    } else if (kind == 1) {
      dst = slab_ptr(p, cb >> 6, b) + tokw;
      rstride = T;
    } else {
      dst = slab_ptr(p, cb >> 6, b) + (size_t)tokw * 64;
      rstride = 64;
    }
#pragma unroll
    for (int hf = 0; hf < 2; ++hf) {
#pragma unroll
      for (int mi = 0; mi < 4; ++mi) {
#pragma unroll
        for (int j = 0; j < 4; ++j) {
          float v0 = acc[hf * 4 + mi][0][j], v1 = acc[hf * 4 + mi][1][j], v2 = acc[hf * 4 + mi][2][j], v3 = acc[hf * 4 + mi][3][j];
          const int rowl = mi * 16 + g * 4 + j;
          const int s = tokw + hf * 64 + rowl;
          if (tr == 1) {
            v0 = silu(v0); v1 = silu(v1); v2 = silu(v2); v3 = silu(v3);
          } else if (tr == 3) {
            if (donorm) {
              float ss = v0 * v0 + v1 * v1 + v2 * v2 + v3 * v3;
              ss += __shfl_xor(ss, 1);
              ss += __shfl_xor(ss, 2);
              ss += __shfl_xor(ss, 4);
              ss += __shfl_xor(ss, 8);
              const float inv = rsqrtf(ss * (1.f / 64.f) + 1e-6f);
              v0 *= inv * gv0; v1 *= inv * gv1; v2 *= inv * gv2; v3 *= inv * gv3;
            }
            if (dorope) {
              float sr, cr, sc, cc;
              sincos_rev((float)(s >> 6) * invf64, sr, cr);
              sincos_rev((float)(s & 63) * invf64, sc, cc);
              const float a1 = v0, a2 = v1, b1 = v2, b2 = v3;
              v0 = a1 * cr - a2 * sr;
              v1 = a2 * cr + a1 * sr;
              v2 = b1 * cc - b2 * sc;
              v3 = b2 * cc + b1 * sc;
            }
          } else if (tr == 4) {
            float sr, cr, sc, cc;
            sincos_rev((float)(s >> 6) * invf32, sr, cr);
            sincos_rev((float)(s & 63) * invf32, sc, cc);
            const float p0 = __shfl_xor(v0, 8), p1 = __shfl_xor(v1, 8), p2 = __shfl_xor(v2, 8), p3 = __shfl_xor(v3, 8);
            v0 = lo8 ? (v0 * cr - p0 * sr) : (v0 * cr + p0 * sr);
            v1 = lo8 ? (v1 * cc - p1 * sc) : (v1 * cc + p1 * sc);
            v2 = lo8 ? (v2 * cr - p2 * sr) : (v2 * cr + p2 * sr);
            v3 = lo8 ? (v3 * cc - p3 * sc) : (v3 * cc + p3 * sc);
          }
          const unsigned u01 = pack2(v0, v1), u23 = pack2(v2, v3);
          if (kind == 1) {
            Tl[(0 * 16 + r) * 72 + rowl] = (u16)u01;
            Tl[(1 * 16 + r) * 72 + rowl] = (u16)(u01 >> 16);
            Tl[(2 * 16 + r) * 72 + rowl] = (u16)u23;
            Tl[(3 * 16 + r) * 72 + rowl] = (u16)(u23 >> 16);
          } else if (tr == 2) {
            Tl[rowl * 72 + 0 * 16 + r] = f2h(v0);
            Tl[rowl * 72 + 1 * 16 + r] = f2h(v1);
            Tl[rowl * 72 + 2 * 16 + r] = f2h(v2);
            Tl[rowl * 72 + 3 * 16 + r] = f2h(v3);
          } else {
            Tl[rowl * 72 + 0 * 16 + r] = (u16)u01;
            Tl[rowl * 72 + 1 * 16 + r] = (u16)(u01 >> 16);
            Tl[rowl * 72 + 2 * 16 + r] = (u16)u23;
            Tl[rowl * 72 + 3 * 16 + r] = (u16)(u23 >> 16);
          }
        }
      }
      __builtin_amdgcn_fence(__ATOMIC_RELEASE, "wavefront");
      u16* dh = (kind == 1) ? dst + hf * 64 : dst + (size_t)(hf * 64) * rstride;
#pragma unroll
      for (int i = 0; i < 8; ++i) {
        const int c = lane + i * 64;
        const int row = c >> 3, cc = c & 7;
        uint4 v = *(const uint4*)&Tl[row * 72 + cc * 8];
        *(uint4*)(dh + (size_t)row * rstride + cc * 8) = v;
      }
      __builtin_amdgcn_fence(__ATOMIC_RELEASE, "wavefront");
    }
  }
  if (!has_next) break;
  t = tn; m0 = m1; n0 = n1; Ag = Agn; Bg = Bgn;
  }
}

DI void phase_inproj(const P& p, int l, char* lds) {
  gemm_phase<0>(p, l, p.H, p.Wt + (size_t)l * NIN * 1024, (MALL / 256) / 8, lds);
}
DI void phase_outproj(const P& p, int l, char* lds) {
  const int mrows = (l == 0) ? MALL : MLAT;
  gemm_phase<1>(p, l, p.H  , p.Wot + (size_t)l * 1024 * 1024, (mrows / 256) / 8, lds);
}

template <int MODE>
DI void attn_item(const P& p, const u16* __restrict__ Q0, const u16* __restrict__ Q1, const u16* __restrict__ Kp,
                  const u16* __restrict__ Vp, int qtok0, int ka0, int na, int kb0, int nb, bool window, float c1, bool has_sink,
                  float sink0, float sink1, int yrow0, int ycol0, float lam, const float* __restrict__ subln, float outscale,
                  char* lds) {
  const int tid = tidx(), lane = tid & 63, w = tid >> 6, r = lane & 15, g = lane >> 4;
  u16* Kbase = (u16*)lds;
  bf16x8 qf[2][2][2];
#pragma unroll
  for (int tt = 0; tt < 2; ++tt)
#pragma unroll
    for (int hh = 0; hh < 2; ++hh) {
      const int tok = qtok0 + w * 32 + tt * 16 + r;
      const u16* base = (hh ? Q1 : Q0) + (size_t)tok * 64;
      if constexpr (MODE == 0) {
        qf[tt][hh][0] = *(const bf16x8*)(base + g * 8);
        qf[tt][hh][1] = *(const bf16x8*)(base + 32 + g * 8);
      } else {
        qf[tt][hh][0] = *(const bf16x8*)(base + hh * 32 + g * 8);
        qf[tt][hh][1] = qf[tt][hh][0];
      }
    }
  f32x4 O[2][2][4];
  float lsum[2][2], nbias[2][2];
  bool first = true;
#pragma unroll
  for (int tt = 0; tt < 2; ++tt)
#pragma unroll
    for (int hh = 0; hh < 2; ++hh) {
      lsum[tt][hh] = 0.f;
      nbias[tt][hh] = 0.f;
#pragma unroll
      for (int dt = 0; dt < 4; ++dt) O[tt][hh][dt] = zero4();
    }
  const int ntile = na + nb;
  const int lrow = tid >> 3, lcc = (tid & 7) * 8;
  const unsigned kvoff = (unsigned)((lrow * 64 + lcc) * 2), vvoff = (unsigned)((lrow * T + lcc) * 2);
  const int krow = (lrow & 32) | (((lrow >> 2) & 1) * 16) | (((lrow >> 3) & 3) * 4) | (lrow & 3);
  const int kwoff = krow * 64 + (((tid & 7) ^ (krow & 7)) * 8);
  const int vwoff = lrow * 64 + (((tid & 7) ^ (lrow & 7)) * 8);
  uint4 kr0, vr0;
#define ALOAD(kt)                                                          \
  kr0 = *(const uint4*)((const char*)(Kp + (size_t)(kt) * 64) + kvoff);     \
  vr0 = *(const uint4*)((const char*)(Vp + (kt)) + vvoff);
  {
    const int kt0 = (0 < na) ? ka0 : kb0;
    ALOAD(kt0)
  }
  __syncthreads();
  *(uint4*)&Kbase[kwoff] = kr0;
  *(uint4*)&Kbase[64 * 64 + vwoff] = vr0;
  for (int it = 0; it < ntile; ++it) {
    const int kt0 = (it < na) ? ka0 + it * 64 : kb0 + (it - na) * 64;
    const bool masked = window && (it < na);
    const u16* Ks = Kbase + (it & 1) * (2 * 64 * 64);
    const u16* Vs = Ks + 64 * 64;
    __syncthreads();
    const bool more = it + 1 < ntile;
    if (more) {
      const int kn = (it + 1 < na) ? ka0 + (it + 1) * 64 : kb0 + (it + 1 - na) * 64;
      ALOAD(kn)
    }
    bool skip = false;
    if (masked) {
      const int qlo = qtok0 + __builtin_amdgcn_readfirstlane(w) * 32;
      skip = (kt0 > qlo + 31 + 128) || (kt0 + 63 < qlo - 128);
    }
    if (!skip) {
    f32x4 S[2][2][2][2];
#pragma unroll
    for (int kh = 0; kh < 2; ++kh) {
      bf16x8 kf[2][2];
#pragma unroll
      for (int t = 0; t < 2; ++t)
#pragma unroll
        for (int s2 = 0; s2 < 2; ++s2)
          kf[t][s2] = *(const bf16x8*)&Ks[(kh * 32 + t * 16 + r) * 64 + (((s2 * 4 + g) ^ (r & 7)) * 8)];
#pragma unroll
      for (int tt = 0; tt < 2; ++tt)
#pragma unroll
        for (int hh = 0; hh < 2; ++hh) {
          f32x4 s0 = zero4(), s1 = zero4();
          if constexpr (MODE == 0) {
            s0 = MFMA(kf[0][0], qf[tt][hh][0], s0);
            s1 = MFMA(kf[1][0], qf[tt][hh][0], s1);
            s0 = MFMA(kf[0][1], qf[tt][hh][1], s0);
            s1 = MFMA(kf[1][1], qf[tt][hh][1], s1);
          } else {
            s0 = MFMA(kf[0][hh], qf[tt][hh][0], s0);
            s1 = MFMA(kf[1][hh], qf[tt][hh][0], s1);
          }
          S[kh][tt][hh][0] = s0;
          S[kh][tt][hh][1] = s1;
        }
    }
    if (masked) {
#pragma unroll
      for (int kh = 0; kh < 2; ++kh)
#pragma unroll
        for (int tt = 0; tt < 2; ++tt) {
          const int qpos = qtok0 + w * 32 + tt * 16 + r;
          const int kp0 = kt0 + kh * 32 + g * 8;
#pragma unroll
          for (int t = 0; t < 2; ++t)
#pragma unroll
            for (int j = 0; j < 4; ++j) {
              int d = kp0 + t * 4 + j - qpos;
              d = d < 0 ? -d : d;
              if (d > 128) { S[kh][tt][0][t][j] = -INFINITY; S[kh][tt][1][t][j] = -INFINITY; }
            }
        }
    }
#pragma unroll
    for (int tt = 0; tt < 2; ++tt)
#pragma unroll
      for (int hh = 0; hh < 2; ++hh) {
        const float nb = nbias[tt][hh];
#pragma unroll
        for (int kh = 0; kh < 2; ++kh)
#pragma unroll
          for (int t = 0; t < 2; ++t) S[kh][tt][hh][t] = S[kh][tt][hh][t] * c1 + nb;
      }
    {
      float mxq[2][2];
      bool need = first;
#pragma unroll
      for (int tt = 0; tt < 2; ++tt)
#pragma unroll
        for (int hh = 0; hh < 2; ++hh) {
          const float m0 = fmaxf(fmaxf(S[0][tt][hh][0][0], S[0][tt][hh][0][1]), S[0][tt][hh][0][2]);
          const float m1 = fmaxf(fmaxf(S[0][tt][hh][1][0], S[0][tt][hh][1][1]), S[0][tt][hh][1][2]);
          const float m2 = fmaxf(fmaxf(S[1][tt][hh][0][0], S[1][tt][hh][0][1]), S[1][tt][hh][0][2]);
          const float m3 = fmaxf(fmaxf(S[1][tt][hh][1][0], S[1][tt][hh][1][1]), S[1][tt][hh][1][2]);
          const float m4 = fmaxf(fmaxf(S[0][tt][hh][0][3], S[0][tt][hh][1][3]), m0);
          const float m5 = fmaxf(fmaxf(S[1][tt][hh][0][3], S[1][tt][hh][1][3]), m1);
          mxq[tt][hh] = fmaxf(fmaxf(m2, m3), fmaxf(m4, m5));
          need = need || (mxq[tt][hh] > 8.f);
        }
      if (__builtin_amdgcn_ballot_w64(need) != 0) {
#pragma unroll
        for (int tt = 0; tt < 2; ++tt)
#pragma unroll
          for (int hh = 0; hh < 2; ++hh) {
            float mx = mxq[tt][hh];
            mx = fmaxf(mx, __shfl_xor(mx, 16));
            mx = fmaxf(mx, __shfl_xor(mx, 32));
            const float d = (mx == -INFINITY) ? 0.f : (first ? mx : fmaxf(mx, 0.f));
            const float alpha = __builtin_amdgcn_exp2f(-d);
            lsum[tt][hh] *= alpha;
            nbias[tt][hh] -= d;
#pragma unroll
            for (int dt = 0; dt < 4; ++dt)
#pragma unroll
              for (int j = 0; j < 4; ++j) O[tt][hh][dt][j] *= alpha;
#pragma unroll
            for (int kh = 0; kh < 2; ++kh)
#pragma unroll
              for (int t = 0; t < 2; ++t) S[kh][tt][hh][t] = S[kh][tt][hh][t] - d;
          }
      }
      first = false;
    }
#pragma unroll
    for (int kh = 0; kh < 2; ++kh) {
#pragma unroll
      for (int tt = 0; tt < 2; ++tt) {
        bf16x8 pf[2];
#pragma unroll
        for (int hh = 0; hh < 2; ++hh) {
          float pv[8];
#pragma unroll
          for (int j = 0; j < 4; ++j) {
            pv[j] = __builtin_amdgcn_exp2f(S[kh][tt][hh][0][j]);
            pv[4 + j] = __builtin_amdgcn_exp2f(S[kh][tt][hh][1][j]);
          }
          lsum[tt][hh] += ((pv[0] + pv[1]) + (pv[2] + pv[3])) + ((pv[4] + pv[5]) + (pv[6] + pv[7]));
          const uint4 pk = make_uint4(pack2(pv[0], pv[1]), pack2(pv[2], pv[3]), pack2(pv[4], pv[5]), pack2(pv[6], pv[7]));
          pf[hh] = __builtin_bit_cast(bf16x8, pk);
        }
#pragma unroll
        for (int dt = 0; dt < 4; ++dt) {
          const bf16x8 vf = *(const bf16x8*)&Vs[(dt * 16 + r) * 64 + (((kh * 4 + g) ^ (r & 7)) * 8)];
          O[tt][0][dt] = MFMA(vf, pf[0], O[tt][0][dt]);
          O[tt][1][dt] = MFMA(vf, pf[1], O[tt][1][dt]);
        }
      }
    }
    }
    if (more) {
      u16* Kn = Kbase + ((it + 1) & 1) * (2 * 64 * 64);
      *(uint4*)&Kn[kwoff] = kr0;
      *(uint4*)&Kn[64 * 64 + vwoff] = vr0;
    }
  }
  float linv[2][2];
#pragma unroll
  for (int tt = 0; tt < 2; ++tt)
#pragma unroll
    for (int hh = 0; hh < 2; ++hh) {
      float lt = lsum[tt][hh];
      lt += __shfl_xor(lt, 16);
      lt += __shfl_xor(lt, 32);
      if (has_sink) lt += __builtin_amdgcn_exp2f((hh ? sink1 : sink0) + nbias[tt][hh]);
      linv[tt][hh] = 1.f / lt;
    }
  if constexpr (MODE == 0) {
    uint2 gg[2][2][4];
#pragma unroll
    for (int tt = 0; tt < 2; ++tt)
#pragma unroll
      for (int hh = 0; hh < 2; ++hh)
#pragma unroll
        for (int dt = 0; dt < 4; ++dt)
          gg[tt][hh][dt] = *(const uint2*)(p.G + (size_t)(yrow0 + w * 32 + tt * 16 + r) * 1024 + ycol0 + hh * 64 + dt * 16 + g * 4);
#pragma unroll
    for (int tt = 0; tt < 2; ++tt) {
      const int row = yrow0 + w * 32 + tt * 16 + r;
#pragma unroll
      for (int hh = 0; hh < 2; ++hh)
#pragma unroll
        for (int dt = 0; dt < 4; ++dt) {
          const int col = ycol0 + hh * 64 + dt * 16 + g * 4;
          const float li = linv[tt][hh];
          const uint2 gq = gg[tt][hh][dt];
          uint2 o;
          o.x = pack2(O[tt][hh][dt][0] * li * bflo(gq.x), O[tt][hh][dt][1] * li * bfhi(gq.x));
          o.y = pack2(O[tt][hh][dt][2] * li * bflo(gq.y), O[tt][hh][dt][3] * li * bfhi(gq.y));
          *(uint2*)(p.H + (size_t)row * 1024 + col) = o;
        }
    }
  } else {
    uint2 gg[2][4];
    float4 sgv[4];
#pragma unroll
    for (int dt = 0; dt < 4; ++dt) sgv[dt] = *(const float4*)(subln + dt * 16 + g * 4);
#pragma unroll
    for (int tt = 0; tt < 2; ++tt)
#pragma unroll
      for (int dt = 0; dt < 4; ++dt)
        gg[tt][dt] = *(const uint2*)(p.G + (size_t)(yrow0 + w * 32 + tt * 16 + r) * 1024 + ycol0 + dt * 16 + g * 4);
#pragma unroll
    for (int tt = 0; tt < 2; ++tt) {
      const int row = yrow0 + w * 32 + tt * 16 + r;
      float ov[4][4];
      float ss = 0.f;
#pragma unroll
      for (int dt = 0; dt < 4; ++dt)
#pragma unroll
        for (int j = 0; j < 4; ++j) {
          const float v = O[tt][0][dt][j] * linv[tt][0] - lam * O[tt][1][dt][j] * linv[tt][1];
          ov[dt][j] = v;
          ss += v * v;
        }
      ss += __shfl_xor(ss, 16);
      ss += __shfl_xor(ss, 32);
      const float rinv = rsqrtf(ss * (1.f / 64.f) + 1e-6f) * outscale;
#pragma unroll
      for (int dt = 0; dt < 4; ++dt) {
        const int col = ycol0 + dt * 16 + g * 4;
        const uint2 gq = gg[tt][dt];
        const float4 sg = sgv[dt];
        uint2 o;
        o.x = pack2(ov[dt][0] * rinv * sg.x * bflo(gq.x), ov[dt][1] * rinv * sg.y * bfhi(gq.x));
        o.y = pack2(ov[dt][2] * rinv * sg.z * bflo(gq.y), ov[dt][3] * rinv * sg.w * bfhi(gq.y));
        *(uint2*)(p.H + (size_t)row * 1024 + col) = o;
      }
    }
  }
}

DI void hgrn_unit(const P& p, int l, int unit, char* lds_all) {
  const int tid512 = tidx();
  const int dir = tid512 >> 8;
  const int tid = tid512 & 255, lane = tid & 63, w = tid >> 6, r = lane & 15, g = lane >> 4;
  char* lds = lds_all + dir * 73728;
  const int b = unit >> 2, h = unit & 3;
  float* Lf = (float*)lds;
  float* Seg = Lf + 64 * 65;
  u16* Qm = (u16*)(Seg + 256);
  u16* Km = Qm + 64 * 72;
  u16* KmT = Km + 64 * 72;
  u16* Vt = KmT + 64 * 72;
  u16* Att = Vt + 64 * 72;
  u16* St = Att + 64 * 72;
  const u16* qs = slab_ptr(p, h, b);
  const u16* is = slab_ptr(p, 4 + h, b);
  const u16* zs = slab_ptr(p, 8 + dir * 4 + h, b);
  float* Og = (dir ? p.OB : p.OF) + (size_t)(b * 4 + h) * T * 64;
  const int tau = tid >> 2, kc = (tid & 3) * 16;
  float lbv[16];
#pragma unroll
  for (int i = 0; i < 16; ++i) {
    if (l == 0) {
      lbv[i] = 0.f;
    } else {
      const float e0 = p.lb_logits[(0 * 2 + dir) * 256 + h * 64 + kc + i];
      const float e1 = p.lb_logits[(1 * 2 + dir) * 256 + h * 64 + kc + i];
      lbv[i] = 1.f / (1.f + __expf(e0 - e1));
    }
  }
  f32x4 Sacc[4];
#pragma unroll
  for (int nt = 0; nt < 4; ++nt) Sacc[nt] = zero4();

  for (int c = 0; c < 36; ++c) {
    int base;
    if (c < 4) base = 2048 + (dir ? (3 - c) : c) * 64;
    else base = (dir ? (31 - (c - 4)) : (c - 4)) * 64;
    const int tok = base + (dir ? 63 - tau : tau);
    float qv[16], kk[16];
    {
      const uint4* qp = (const uint4*)(qs + (size_t)tok * 64 + kc);
      const uint4* zp = (const uint4*)(zs + (size_t)tok * 64 + kc);
      const uint4* vp = (const uint4*)(is + (size_t)tok * 64 + kc);
      const uint4 q0 = qp[0], q1 = qp[1], z0 = zp[0], z1 = zp[1], v0 = vp[0], v1 = vp[1];
      const unsigned qw[8] = {q0.x, q0.y, q0.z, q0.w, q1.x, q1.y, q1.z, q1.w};
      const unsigned zw[8] = {z0.x, z0.y, z0.z, z0.w, z1.x, z1.y, z1.z, z1.w};
      const unsigned vw[8] = {v0.x, v0.y, v0.z, v0.w, v1.x, v1.y, v1.z, v1.w};
#pragma unroll
      for (int e = 0; e < 8; ++e) {
        qv[2 * e] = bflo(qw[e]);
        qv[2 * e + 1] = bfhi(qw[e]);
        const float za = hflo(zw[e]), zb = hfhi(zw[e]);
        const float fa = lbv[2 * e] + (1.f - lbv[2 * e]) / (1.f + __expf(-za));
        const float fb = lbv[2 * e + 1] + (1.f - lbv[2 * e + 1]) / (1.f + __expf(-zb));
        kk[2 * e] = 1.f - fa;
        kk[2 * e + 1] = 1.f - fb;
        Lf[tau * 65 + kc + 2 * e] = __logf(fa);
        Lf[tau * 65 + kc + 2 * e + 1] = __logf(fb);
        Vt[(kc + 2 * e) * 72 + tau] = (u16)(vw[e] & 0xffffu);
        Vt[(kc + 2 * e + 1) * 72 + tau] = (u16)(vw[e] >> 16);
      }
    }
    __syncthreads();
    {
      const int k = tid & 63, sg = tid >> 6;
      float run = 0.f;
#pragma unroll
      for (int i = 0; i < 16; ++i) {
        float* ptr = &Lf[(sg * 16 + i) * 65 + k];
        run += *ptr;
        *ptr = run;
      }
      Seg[sg * 64 + k] = run;
    }
    __syncthreads();
    {
      const int sg = tau >> 4;
      unsigned qmw[8], kmw[8];
#pragma unroll
      for (int e = 0; e < 8; ++e) {
        float qq[2], km2[2];
#pragma unroll
        for (int u = 0; u < 2; ++u) {
          const int i = 2 * e + u, k = kc + i;
          const float s0 = Seg[k], s1 = Seg[64 + k], s2 = Seg[128 + k];
          const float off = (sg > 0 ? s0 : 0.f) + (sg > 1 ? s1 : 0.f) + (sg > 2 ? s2 : 0.f);
          const float bc = Lf[tau * 65 + k] + off;
          const float rr = Lf[31 * 65 + k] + s0;
          qq[u] = qv[i] * __expf(bc - rr);
          km2[u] = kk[i] * __expf(rr - bc);
          KmT[k * 72 + tau] = f2bf(km2[u]);
        }
        qmw[e] = pack2(qq[0], qq[1]);
        kmw[e] = pack2(km2[0], km2[1]);
      }
      *(uint4*)&Qm[tau * 72 + kc] = make_uint4(qmw[0], qmw[1], qmw[2], qmw[3]);
      *(uint4*)&Qm[tau * 72 + kc + 8] = make_uint4(qmw[4], qmw[5], qmw[6], qmw[7]);
      *(uint4*)&Km[tau * 72 + kc] = make_uint4(kmw[0], kmw[1], kmw[2], kmw[3]);
      *(uint4*)&Km[tau * 72 + kc + 8] = make_uint4(kmw[4], kmw[5], kmw[6], kmw[7]);
#pragma unroll
      for (int nt = 0; nt < 4; ++nt) {
        const int k = nt * 16 + r;
        const float er = __expf(Lf[31 * 65 + k] + Seg[k]);
#pragma unroll
        for (int j = 0; j < 4; ++j) St[(w * 16 + g * 4 + j) * 72 + k] = f2bf(Sacc[nt][j] * er);
      }
    }
    __syncthreads();
    bf16x8 aq[2];
#pragma unroll
    for (int ks = 0; ks < 2; ++ks) aq[ks] = *(const bf16x8*)&Qm[(w * 16 + r) * 72 + ks * 32 + g * 8];
    f32x4 oacc[4];
#pragma unroll
    for (int nt = 0; nt < 4; ++nt) {
      f32x4 a = zero4();
#pragma unroll
      for (int ks = 0; ks < 2; ++ks) {
        const bf16x8 bk = *(const bf16x8*)&Km[(nt * 16 + r) * 72 + ks * 32 + g * 8];
        a = MFMA(aq[ks], bk, a);
      }
#pragma unroll
      for (int j = 0; j < 4; ++j) {
        const bool keep = (nt * 16 + r) <= (w * 16 + g * 4 + j);
        const float v = keep ? a[j] : 0.f;
        Att[(w * 16 + g * 4 + j) * 72 + nt * 16 + r] = f2bf(v);
      }
    }
#pragma unroll
    for (int nt = 0; nt < 4; ++nt) {
      f32x4 a = zero4();
#pragma unroll
      for (int ks = 0; ks < 2; ++ks) {
        const bf16x8 bs = *(const bf16x8*)&St[(nt * 16 + r) * 72 + ks * 32 + g * 8];
        a = MFMA(aq[ks], bs, a);
      }
      oacc[nt] = a;
    }
    __syncthreads();
    bf16x8 aa[2], av[2];
#pragma unroll
    for (int ks = 0; ks < 2; ++ks) {
      aa[ks] = *(const bf16x8*)&Att[(w * 16 + r) * 72 + ks * 32 + g * 8];
      av[ks] = *(const bf16x8*)&Vt[(w * 16 + r) * 72 + ks * 32 + g * 8];
    }
#pragma unroll
    for (int nt = 0; nt < 4; ++nt) {
#pragma unroll
      for (int ks = 0; ks < 2; ++ks) {
        const bf16x8 bv = *(const bf16x8*)&Vt[(nt * 16 + r) * 72 + ks * 32 + g * 8];
        oacc[nt] = MFMA(aa[ks], bv, oacc[nt]);
      }
#pragma unroll
      for (int j = 0; j < 4; ++j) {
        const int t = w * 16 + g * 4 + j;
        const int tk = base + (dir ? 63 - t : t);
        Og[(size_t)tk * 64 + nt * 16 + r] = oacc[nt][j];
      }
    }
#pragma unroll
    for (int nt = 0; nt < 4; ++nt) {
      f32x4 u = zero4();
#pragma unroll
      for (int ks = 0; ks < 2; ++ks) {
        const bf16x8 bk = *(const bf16x8*)&KmT[(nt * 16 + r) * 72 + ks * 32 + g * 8];
        u = MFMA(av[ks], bk, u);
      }
      const int k = nt * 16 + r;
      const float s0 = Seg[k], s1 = Seg[64 + k], s2 = Seg[128 + k], s3 = Seg[192 + k];
      const float blast = s0 + s1 + s2 + s3;
      const float rk = Lf[31 * 65 + k] + s0;
      const float e1 = __expf(blast), e2 = __expf(blast - rk);
#pragma unroll
      for (int j = 0; j < 4; ++j) Sacc[nt][j] = e1 * Sacc[nt][j] + e2 * u[j];
    }
    __syncthreads();
  }
  __threadfence();
  __syncthreads();
  {
    const float* of = p.OF + (size_t)(b * 4 + h) * T * 64;
    const float* ob = p.OB + (size_t)(b * 4 + h) * T * 64;
    const float* ng = p.hg_norm_g + l * 64;
    const int ntok = (l == 0) ? T : SEQ;
    for (int idx0 = tid512; idx0 < ntok * 16; idx0 += 4 * NT) {
      float4 a4[4], b4[4];
      uint2 g4[4];
#pragma unroll
      for (int u = 0; u < 4; ++u) {
        const int idx = idx0 + u * NT;
        const int tok = idx >> 4, dv4 = idx & 15;
        const int row = tok < 2048 ? b * 2048 + tok : MLAT + b * 256 + (tok - 2048);
        a4[u] = *(const float4*)(of + (size_t)tok * 64 + dv4 * 4);
        b4[u] = *(const float4*)(ob + (size_t)tok * 64 + dv4 * 4);
        g4[u] = *(const uint2*)(p.G + (size_t)row * 1024 + h * 64 + dv4 * 4);
      }
#pragma unroll
      for (int u = 0; u < 4; ++u) {
        const int idx = idx0 + u * NT;
        const int tok = idx >> 4, dv4 = idx & 15;
        const float o0 = a4[u].x + b4[u].x, o1 = a4[u].y + b4[u].y, o2 = a4[u].z + b4[u].z, o3 = a4[u].w + b4[u].w;
        float ss = o0 * o0 + o1 * o1 + o2 * o2 + o3 * o3;
        ss += __shfl_xor(ss, 1);
        ss += __shfl_xor(ss, 2);
        ss += __shfl_xor(ss, 4);
        ss += __shfl_xor(ss, 8);
        const float rinv = rsqrtf(ss * (1.f / 64.f) + 1e-6f);
        const int row = tok < 2048 ? b * 2048 + tok : MLAT + b * 256 + (tok - 2048);
        const int col = h * 64 + dv4 * 4;
        const float4 n4 = *(const float4*)(ng + dv4 * 4);
        uint2 o;
        o.x = pack2(o0 * rinv * n4.x * bflo(g4[u].x), o1 * rinv * n4.y * bfhi(g4[u].x));
        o.y = pack2(o2 * rinv * n4.z * bflo(g4[u].y), o3 * rinv * n4.w * bfhi(g4[u].y));
        *(uint2*)(p.H + (size_t)row * 1024 + col) = o;
      }
    }
  }
  __syncthreads();
}

DI void phase_mix(const P& p, int l, int rep, char* lds) {
  __shared__ int s_item;
  const int nitems = 64 + 512 + 256 + 256 + (l == 0 ? 128 : 0);
  const float lam_init = (l == 0) ? 0.2f : (0.8f - 0.6f * 0.7408182206817179f);
  const float* dl = p.df_lam + l * 128;
  float d01 = 0.f, d23 = 0.f;
  for (int i = 0; i < 32; ++i) {
    d01 += dl[i] * dl[32 + i];
    d23 += dl[64 + i] * dl[96 + i];
  }
  const float lam = expf(d01) - expf(d23) + lam_init;
  const float* subln = p.df_subln + l * 64;
  const float cB = 0.125f * LOG2E, cC = 0.17677669529663687f * LOG2E;
  while (true) {
    if (tidx() == 0) s_item = atomicAdd(&p.ctr[l + 2 * rep], 1);
    __syncthreads();
    int it = __builtin_amdgcn_readfirstlane(s_item);
    __syncthreads();
    if (it >= nitems) break;
    if (it < 64) {
      hgrn_unit(p, l, it, lds);
      continue;
    }
    it -= 64;
    int mode, b, hq, qb, sq0, sq1, sk, sv, qtok0, ka0, na, kb0 = 2048, nb = 0, yrow0, ycol0;
    bool window = false, has_sink = false, isctx = false;
    int kind;
    if (it < 512) { kind = 0; b = it >> 5; hq = (it >> 3) & 3; qb = it & 7; }
    else if (it < 768) { it -= 512; kind = 1; b = it >> 4; hq = (it >> 3) & 1; qb = it & 7; }
    else if (it < 1024) { it -= 768; kind = 2; b = it >> 4; hq = (it >> 3) & 1; qb = it & 7; }
    else if (it < 1088) { it -= 1024; kind = 0; isctx = true; b = it >> 2; hq = it & 3; qb = 0; }
    else if (it < 1120) { it -= 1088; kind = 1; isctx = true; b = it >> 1; hq = it & 1; qb = 0; }
    else { it -= 1120; kind = 2; isctx = true; b = it >> 1; hq = it & 1; qb = 0; }
    if (kind == 0) { mode = 1; sq0 = 24 + hq; sq1 = sq0; sk = 28 + hq; sv = 32 + hq; ycol0 = 512 + hq * 64; }
    else if (kind == 1) { mode = 0; sq0 = 16 + hq * 2; sq1 = sq0 + 1; sk = 20 + hq; sv = 22 + hq; ycol0 = 256 + hq * 128; }
    else { mode = 0; sq0 = 36 + hq * 2; sq1 = sq0 + 1; sk = 40 + hq; sv = 42 + hq; ycol0 = 768 + hq * 128; has_sink = true; }
    if (isctx) {
      qtok0 = 2048; ka0 = 2048; na = 4; yrow0 = MLAT + b * 256;
    } else {
      qtok0 = qb * 256; yrow0 = b * 2048 + qb * 256;
      if (kind == 2) {
        window = true;
        ka0 = qtok0 - 128 < 0 ? 0 : qtok0 - 128;
        const int ka1 = qtok0 + 384 > 2048 ? 2048 : qtok0 + 384;
        na = (ka1 - ka0) >> 6; nb = 4;
      } else { ka0 = 0; na = 36; }
    }
    float sk0 = 0.f, sk1 = 0.f;
    if (has_sink) { sk0 = p.wn_sink[l * 4 + hq * 2] * LOG2E; sk1 = p.wn_sink[l * 4 + hq * 2 + 1] * LOG2E; }
    if (mode == 1)
      attn_item<1>(p, slab_ptr(p, sq0, b), slab_ptr(p, sq1, b), slab_ptr(p, sk, b), slab_ptr(p, sv, b), qtok0, ka0, na, kb0, nb, window,
                   cC, has_sink, sk0, sk1, yrow0, ycol0, lam, subln, 1.f - lam_init, lds);
    else
      attn_item<0>(p, slab_ptr(p, sq0, b), slab_ptr(p, sq1, b), slab_ptr(p, sk, b), slab_ptr(p, sv, b), qtok0, ka0, na, kb0, nb, window,
                   cB, has_sink, sk0, sk1, yrow0, ycol0, lam, subln, 1.f, lds);
  }
}

DI void phase_ln(const P& p, int l) {
  const int tid = tidx(); const int lane = tid & 63, w = tid >> 6;
  const int nrows = (l == 0) ? MALL : MLAT;
  const float* Zb = (const float*)p.slab;
  const float* lg = p.ln_g + l * 1024;
  const float* lb = p.ln_b + l * 1024;
  const int gw = blockIdx.x * 8 + w, nw = gridDim.x * 8;
  const int per = (nrows + nw - 1) / nw;
  const int r0 = gw * per, r1 = (r0 + per < nrows) ? r0 + per : nrows;
  float4 g4[4], b4[4];
#pragma unroll
  for (int i = 0; i < 4; ++i) {
    g4[i] = *(const float4*)(lg + i * 256 + lane * 4);
    b4[i] = *(const float4*)(lb + i * 256 + lane * 4);
  }
  for (int row = r0; row < r1; row += 2) {
    const bool two = row + 1 < r1;
    const int rowb = two ? row + 1 : row;
    float4 v[2][4];
#pragma unroll
    for (int i = 0; i < 4; ++i) {
      v[0][i] = *(const float4*)(Zb + (size_t)row * 1024 + i * 256 + lane * 4);
      v[1][i] = *(const float4*)(Zb + (size_t)rowb * 1024 + i * 256 + lane * 4);
    }
#pragma unroll
    for (int h = 0; h < 2; ++h) {
      if (h && !two) break;
      const int rr = h ? rowb : row;
      float s = 0.f;
#pragma unroll
      for (int i = 0; i < 4; ++i) s += (v[h][i].x + v[h][i].y) + (v[h][i].z + v[h][i].w);
#pragma unroll
      for (int o = 32; o >= 1; o >>= 1) s += __shfl_xor(s, o);
      const float mean = s * (1.f / 1024.f);
      float q = 0.f;
#pragma unroll
      for (int i = 0; i < 4; ++i) {
        v[h][i].x -= mean; v[h][i].y -= mean; v[h][i].z -= mean; v[h][i].w -= mean;
        q += (v[h][i].x * v[h][i].x + v[h][i].y * v[h][i].y) + (v[h][i].z * v[h][i].z + v[h][i].w * v[h][i].w);
      }
#pragma unroll
      for (int o = 32; o >= 1; o >>= 1) q += __shfl_xor(q, o);
      const float rstd = rsqrtf(q * (1.f / 1024.f) + 1e-5f);
      const int mr = rr < MLAT ? (rr >> 11) : 16;
      const float* md = p.mod + (size_t)(1 * 17 + mr) * 3072;
#pragma unroll
      for (int i = 0; i < 4; ++i) {
        const int col = i * 256 + lane * 4;
        float4 y;
        y.x = v[h][i].x * rstd * g4[i].x + b4[i].x;
        y.y = v[h][i].y * rstd * g4[i].y + b4[i].y;
        y.z = v[h][i].z * rstd * g4[i].z + b4[i].z;
        y.w = v[h][i].w * rstd * g4[i].w + b4[i].w;
        if (l == 1 || rr < MLAT) *(float4*)(p.out + (size_t)rr * 1024 + col) = y;
        if (l == 0) {
          const float4 sh = *(const float4*)(md + col), sc = *(const float4*)(md + 1024 + col);
          uint2 o;
          o.x = pack2(y.x * (1.f + sc.x) + sh.x, y.y * (1.f + sc.y) + sh.y);
          o.y = pack2(y.z * (1.f + sc.z) + sh.z, y.w * (1.f + sc.w) + sh.w);
          *(uint2*)(p.H + (size_t)rr * 1024 + col) = o;
        }
      }
    }
  }
}


#define XB_TMO      128
#define XB_XCNT(j)  (256  + 64 * (j))
#define XB_XSUB(j)  (1280 + 64 * (j))
#define XB_XGEN(j)  (2304 + 64 * (j))
#define XB_TOP      3328
#define XB_TOPGEN   3392
#define XCD_BAR_WORDS 3456
#define XB_SPIN_CAP (1u << 18)
#define LAS __attribute__((address_space(3)))

__device__ __forceinline__ unsigned xb_ld(unsigned* p)              { return __hip_atomic_load(p, __ATOMIC_RELAXED, __HIP_MEMORY_SCOPE_AGENT); }
__device__ __forceinline__ unsigned xb_add(unsigned* p, unsigned v) { return __hip_atomic_fetch_add(p, v, __ATOMIC_RELAXED, __HIP_MEMORY_SCOPE_AGENT); }
__device__ __forceinline__ unsigned xb_xcc_id() { return (unsigned)__builtin_amdgcn_s_getreg((3 << 11) | 20) & 0xFu; }
#define XB_SPIN(cond, bar) do { unsigned _sp = 0; while (cond) { __builtin_amdgcn_s_sleep(1); \
    if ((++_sp & 255u) == 0u) { if (xb_ld(&(bar)[XB_TMO])) break; if (_sp > XB_SPIN_CAP) { atomicAdd(&(bar)[XB_TMO], 1u); break; } } } } while (0)

struct XcdBarrier {
    unsigned* bar; unsigned x;
    volatile LAS unsigned* st;
};

__device__ __forceinline__ XcdBarrier xcd_barrier_post(unsigned* bar, volatile LAS unsigned* st) {
    XcdBarrier b; b.bar = bar; b.x = xb_xcc_id(); b.st = st;
    if (threadIdx.x == 0) (void)xb_add(&bar[XB_XCNT(b.x)], 1u);
    return b;
}
__device__ __forceinline__ void xcd_barrier_complete(unsigned* bar, unsigned x, unsigned& nloc, unsigned& nx) {
    const unsigned G = gridDim.x * gridDim.y * gridDim.z;
    unsigned sum, cnt, mine, sp = 0u;
    for (;;) {
        sum = 0u; cnt = 0u; mine = 0u;
#pragma unroll
        for (unsigned j = 0; j < 16; ++j) { const unsigned c = xb_ld(&bar[XB_XCNT(j)]); sum += c; cnt += (c > 0u) ? 1u : 0u; mine = (j == x) ? c : mine; }
        if (sum == G) break;
        __builtin_amdgcn_s_sleep(1);
        if ((++sp & 255u) == 0u) { if (xb_ld(&bar[XB_TMO])) break; if (sp > XB_SPIN_CAP) { atomicAdd(&bar[XB_TMO], 1u); break; } }
    }
    nloc = mine > 0u ? mine : 1u; nx = cnt > 0u ? cnt : 1u;
}

__device__ __forceinline__ void xcd_barrier(const XcdBarrier& b) {
    asm volatile("s_waitcnt vmcnt(0)" ::: "memory");
    __syncthreads();
    if (threadIdx.x == 0) {
        unsigned* bar = b.bar;
        __builtin_amdgcn_s_waitcnt(0);
        unsigned nloc = b.st[0], nx = b.st[1];
        if (nloc == 0u) { xcd_barrier_complete(bar, b.x, nloc, nx); b.st[0] = nloc; b.st[1] = nx; }
        const unsigned old = xb_add(&bar[XB_XSUB(b.x)], 1u);
        const unsigned gen = old / nloc;
        if (old + 1u == (gen + 1u) * nloc) {
            __builtin_amdgcn_fence(__ATOMIC_RELEASE, "agent");
            asm volatile("s_waitcnt vmcnt(0)" ::: "memory");
            const unsigned og = xb_add(&bar[XB_TOP], 1u);
            const unsigned tg = og / nx;
            if (og + 1u == (tg + 1u) * nx) xb_add(&bar[XB_TOPGEN], 1u);
            else XB_SPIN(xb_ld(&bar[XB_TOPGEN]) == tg, bar);
            __builtin_amdgcn_fence(__ATOMIC_ACQUIRE, "agent");
            xb_add(&bar[XB_XGEN(b.x)], 1u);
            asm volatile("s_waitcnt vmcnt(0)" ::: "memory");
        } else {
            XB_SPIN(xb_ld(&bar[XB_XGEN(b.x)]) == gen, bar);
            __builtin_amdgcn_fence(__ATOMIC_ACQUIRE, "agent");
            asm volatile("s_waitcnt vmcnt(0)" ::: "memory");
        }
    }
    __syncthreads();
}


__global__ void __launch_bounds__(512, 2) mega(P p) {
  extern __shared__ __attribute__((aligned(16))) char lds[];
  __shared__ uint4 xb_words;
  if (threadIdx.x == 0) xb_words = make_uint4(0u, 0u, 0u, 0u);
  __syncthreads();
  const XcdBarrier xb = xcd_barrier_post(p.xbar, (volatile LAS unsigned*)&xb_words);
  for (int ph = p.pb; ph < p.pe; ++ph) {
    if (ph == 0) phase_prep(p, lds);
    else if (ph == 1) phase_h0(p);
    else {
      const int l = (ph - 2) >> 2, s = (ph - 2) & 3;
      if (s == 0) { for (int rr = 0; rr < REP_INPROJ; ++rr) { if (rr) cg::this_grid().sync(); phase_inproj(p, l, lds); } }
      else if (s == 1) { for (int rr = 0; rr < REP_MIX; ++rr) { if (rr) cg::this_grid().sync(); phase_mix(p, l, rr, lds); } }
      else if (s == 2) { for (int rr = 0; rr < REP_OUT; ++rr) { if (rr) cg::this_grid().sync(); phase_outproj(p, l, lds); } }
      else phase_ln(p, l);
    }
    if (ph + 1 < p.pe) {
      if (p.pe < 0) cg::this_grid().sync();
      xcd_barrier(xb);
    }
  }
}

extern "C" void kernel_launch(void* const* d_in, const int* in_sizes, int n_in, void* d_out, int out_size, void* d_ws,
                              size_t ws_size, hipStream_t stream) {
  static int grid_blocks = 0;
  if (!grid_blocks) {
    int dev = 0, cus = 0, per_cu = 0;
    hipGetDevice(&dev);
    hipDeviceGetAttribute(&cus, hipDeviceAttributeMultiprocessorCount, dev);
    hipFuncSetAttribute((const void*)mega, hipFuncAttributeMaxDynamicSharedMemorySize, LDS_BYTES);
    hipOccupancyMaxActiveBlocksPerMultiprocessor(&per_cu, (const void*)mega, NT, LDS_BYTES);
    per_cu = 1;
    grid_blocks = cus * per_cu;
  }
  P p{};
  p.x = (const float*)d_in[0]; p.c = (const float*)d_in[1]; p.ctx = (const float*)d_in[2]; p.c_ctx = (const float*)d_in[3];
  p.w_in = (const float*)d_in[4]; p.w_out = (const float*)d_in[5]; p.w_ada = (const float*)d_in[6]; p.b_ada = (const float*)d_in[7];
  p.ln_g = (const float*)d_in[8]; p.ln_b = (const float*)d_in[9]; p.lb_logits = (const float*)d_in[10];
  p.hg_norm_g = (const float*)d_in[11]; p.ga_qn = (const float*)d_in[12]; p.ga_kn = (const float*)d_in[13];
  p.df_lam = (const float*)d_in[14]; p.df_subln = (const float*)d_in[15]; p.wn_sink = (const float*)d_in[16];
  p.out = (float*)d_out;
  char* ws = (char*)d_ws;
  size_t off = 0;
  auto take = [&](size_t bytes) { char* q = ws + off; off += (bytes + 255) & ~(size_t)255; return q; };
  p.ctr = (int*)take(256);
  p.xbar = (unsigned*)take(16384);
  p.mod = (float*)take((size_t)2 * 17 * 3072 * 4);
  p.Wt = (u16*)take((size_t)2 * NIN * 1024 * 2);
  p.Wot = (u16*)take((size_t)2 * 1024 * 1024 * 2);
  p.H = (u16*)take((size_t)MALL * 1024 * 2);
  p.G = (u16*)take((size_t)MALL * 1024 * 2);
  p.OF = (float*)take((size_t)NB * 4 * T * 64 * 4);
  p.OB = (float*)take((size_t)NB * 4 * T * 64 * 4);
  p.slab = (u16*)take((size_t)44 * 16 * T * 64 * 2);
  if (off > ws_size) { fprintf(stderr, "workspace too small: need %zu have %zu\n", off, ws_size); return; }
  hipMemsetAsync(p.ctr, 0, 256 + 16384, stream);
#if MULTI_LAUNCH
  for (int ph = 0; ph < NPHASE; ++ph) {
    p.pb = ph; p.pe = ph + 1;
    hipLaunchKernelGGL(mega, dim3(grid_blocks), dim3(NT), LDS_BYTES, stream, p);
  }
#else
  p.pb = 0; p.pe = NPHASE;
  void* args[] = {&p};
  hipError_t e = hipLaunchCooperativeKernel((const void*)mega, dim3(grid_blocks), dim3(NT), args, LDS_BYTES, stream);
  if (e != hipSuccess) fprintf(stderr, "cooperative launch failed: %s (grid %d)\n", hipGetErrorString(e), grid_blocks);
#endif
}
```

```cpp
#include <hip/hip_runtime.h>
#include <hip/hip_cooperative_groups.h>
#include <cstdio>
namespace cg = cooperative_groups;

typedef unsigned short u16;
typedef __attribute__((ext_vector_type(8))) short bf16x8;
typedef __attribute__((ext_vector_type(4))) float f32x4;
#define DI __device__ __forceinline__
#define MFMA(a, b, c) __builtin_amdgcn_mfma_f32_16x16x32_bf16((a), (b), (c), 0, 0, 0)

#ifndef REP_INPROJ
#define REP_INPROJ 1
#endif
#ifndef REP_MIX
#define REP_MIX 1
#endif
#ifndef REP_OUT
#define REP_OUT 1
#endif
#ifndef MULTI_LAUNCH
#define MULTI_LAUNCH 0
#endif

constexpr int NB = 16, SEQ = 2048, LC = 256, T = 2304, DM = 1024, NIN = 3840;
constexpr int MLAT = NB * SEQ;
constexpr int MALL = MLAT + NB * LC;
constexpr int LDS_BYTES = 147456;
constexpr int NT = 512;
constexpr int NPHASE = 10;
constexpr float LOG2E = 1.4426950408889634f;

struct P {
  const float *x, *c, *ctx, *c_ctx, *w_in, *w_out, *w_ada, *b_ada, *ln_g, *ln_b, *lb_logits, *hg_norm_g, *ga_qn, *ga_kn,
      *df_lam, *df_subln, *wn_sink;
  float* out;
  u16 *Wt, *Wot, *H, *slab, *G;
  float *mod, *OF, *OB;
  int* ctr;
  unsigned* xbar;
  int pb, pe;
};

typedef __bf16 bf2_t __attribute__((ext_vector_type(2)));
typedef float f2_t __attribute__((ext_vector_type(2)));
DI unsigned pack2(float a, float b) {
  f2_t v = {a, b};
  return __builtin_bit_cast(unsigned, __builtin_convertvector(v, bf2_t));
}
DI u16 f2bf(float x) { return (u16)pack2(x, 0.f); }
DI float bflo(unsigned w) { return __uint_as_float(w << 16); }
DI float bfhi(unsigned w) { return __uint_as_float(w & 0xffff0000u); }
DI float hflo(unsigned w) { return (float)__builtin_bit_cast(_Float16, (u16)(w & 0xffffu)); }
DI float hfhi(unsigned w) { return (float)__builtin_bit_cast(_Float16, (u16)(w >> 16)); }
DI u16 f2h(float x) { return __builtin_bit_cast(u16, (_Float16)x); }
DI float silu(float v) { return v * __builtin_amdgcn_rcpf(1.f + __builtin_amdgcn_exp2f(-1.4426950408889634f * v)); }
DI void sincos_rev(float ang, float& s, float& c) {
  float rev = ang * 0.15915494309189535f;
  rev -= rintf(rev);
  s = __builtin_amdgcn_sinf(rev);
  c = __builtin_amdgcn_cosf(rev);
}
DI u16* slab_ptr(const P& p, int sidx, int b) { return p.slab + (size_t)(sidx * 16 + b) * (size_t)(T * 64); }
DI int tidx() { int t = threadIdx.x; asm volatile("" : "+v"(t)); return t; }
DI f32x4 zero4() { f32x4 z = {0.f, 0.f, 0.f, 0.f}; return z; }

DI void mod_item(const P& p, int item, char* lds) {
  const int tid = tidx(), lane = tid & 63, w = tid >> 6;
  const int l = item / 96, cb = item % 96;
  float* sv = (float*)lds;
  for (int i = tid; i < 17 * 1024; i += NT) {
    int r = i >> 10, k = i & 1023;
    float v = r < 16 ? p.c[r * 1024 + k] : p.c_ctx[k];
    sv[i] = silu(v);
  }
  __syncthreads();
  const int c = tid & 31, ks = tid >> 5, n = cb * 32 + c;
  const float* W = p.w_ada + (size_t)l * 1024 * 3072 + n;
  float acc[17];
#pragma unroll
  for (int r = 0; r < 17; ++r) acc[r] = 0.f;
  for (int k = ks * 64; k < ks * 64 + 64; k += 8) {
    float wv[8];
#pragma unroll
    for (int u = 0; u < 8; ++u) wv[u] = W[(size_t)(k + u) * 3072];
#pragma unroll
    for (int u = 0; u < 8; ++u)
#pragma unroll
      for (int r = 0; r < 17; ++r) acc[r] += sv[r * 1024 + k + u] * wv[u];
  }
#pragma unroll
  for (int r = 0; r < 17; ++r) acc[r] += __shfl_xor(acc[r], 32);
  __syncthreads();
  float* red = (float*)lds;
  if (lane < 32) {
#pragma unroll
    for (int r = 0; r < 17; ++r) red[(w * 17 + r) * 32 + c] = acc[r];
  }
  __syncthreads();
  for (int i = tid; i < 17 * 32; i += NT) {
    int r = i >> 5, cc = i & 31;
    float sum = 0.f;
#pragma unroll
    for (int ww = 0; ww < 8; ++ww) sum += red[(ww * 17 + r) * 32 + cc];
    int nn = cb * 32 + cc;
    p.mod[(size_t)(l * 17 + r) * 3072 + nn] = sum + p.b_ada[l * 3072 + nn];
  }
  __syncthreads();
}

DI void transpose_item(const float* __restrict__ W, u16* __restrict__ Wt, int N, int kt, int nt2, char* lds) {
  const int tid512 = tidx();
  const int hb = tid512 >> 8, tid = tid512 & 255, nt = nt2 * 2 + hb;
  u16* tile = (u16*)lds + hb * (64 * 72);
  {
    const int r = tid >> 2, cs = (tid & 3) * 16;
    const float* src = W + (size_t)(kt * 64 + r) * N + nt * 64 + cs;
    float4 v[4];
#pragma unroll
    for (int q = 0; q < 4; ++q) v[q] = *(const float4*)(src + q * 4);
#pragma unroll
    for (int q = 0; q < 4; ++q) {
      const unsigned u01 = pack2(v[q].x, v[q].y), u23 = pack2(v[q].z, v[q].w);
      tile[(cs + q * 4 + 0) * 72 + r] = (u16)u01;
      tile[(cs + q * 4 + 1) * 72 + r] = (u16)(u01 >> 16);
      tile[(cs + q * 4 + 2) * 72 + r] = (u16)u23;
      tile[(cs + q * 4 + 3) * 72 + r] = (u16)(u23 >> 16);
    }
  }
  __syncthreads();
  {
    const int n = tid >> 2, ks = (tid & 3) * 16;
    uint4 a = *(const uint4*)&tile[n * 72 + ks];
    uint4 b = *(const uint4*)&tile[n * 72 + ks + 8];
    u16* dst = Wt + (size_t)(nt * 64 + n) * 1024 + kt * 64 + ks;
    *(uint4*)dst = a;
    *(uint4*)(dst + 8) = b;
  }
  __syncthreads();
}

DI void phase_prep(const P& p, char* lds) {
  for (int it = blockIdx.x; it < 192 + 960 + 256; it += gridDim.x) {
    if (it < 192) {
      mod_item(p, it, lds);
    } else if (it < 192 + 960) {
      int t = it - 192;
      int l = t / 480, rem = t % 480;
      int kt = rem / 30, nt2 = rem % 30;
      transpose_item(p.w_in + (size_t)l * 1024 * NIN, p.Wt + (size_t)l * NIN * 1024, NIN, kt, nt2, lds);
    } else {
      int t = it - 192 - 960;
      int l = t >> 7, rem = t & 127;
      int kt = rem >> 3, nt2 = rem & 7;
      transpose_item(p.w_out + (size_t)l * 1024 * 1024, p.Wot + (size_t)l * 1024 * 1024, 1024, kt, nt2, lds);
    }
  }
}

DI void phase_h0(const P& p) {
  const int tid = tidx(), lane = tid & 63, w = tid >> 6;
  const int gw = blockIdx.x * 8 + w, nw = gridDim.x * 8;
  const int per = (MALL + nw - 1) / nw;
  const int r0 = gw * per, r1 = (r0 + per < MALL) ? r0 + per : MALL;
  int cur_mr = -1;
  float4 sh[4], sc[4];
  for (int row = r0; row < r1; row += 2) {
    const bool two = row + 1 < r1;
    const int rowb = two ? row + 1 : row;
    const float* sa = row < MLAT ? p.x + (size_t)row * 1024 : p.ctx + (size_t)(row - MLAT) * 1024;
    const float* sb = rowb < MLAT ? p.x + (size_t)rowb * 1024 : p.ctx + (size_t)(rowb - MLAT) * 1024;
    float4 va[4], vb[4];
#pragma unroll
    for (int i = 0; i < 4; ++i) {
      va[i] = *(const float4*)(sa + i * 256 + lane * 4);
      vb[i] = *(const float4*)(sb + i * 256 + lane * 4);
    }
#pragma unroll
    for (int half = 0; half < 2; ++half) {
      const int rr = half ? rowb : row;
      if (half && !two) break;
      const int mr = rr < MLAT ? (rr >> 11) : 16;
      if (mr != cur_mr) {
        cur_mr = mr;
        const float* md = p.mod + (size_t)mr * 3072;
#pragma unroll
        for (int i = 0; i < 4; ++i) {
          sh[i] = *(const float4*)(md + i * 256 + lane * 4);
          sc[i] = *(const float4*)(md + 1024 + i * 256 + lane * 4);
        }
      }
#pragma unroll
      for (int i = 0; i < 4; ++i) {
        const float4 v = half ? vb[i] : va[i];
        uint2 o;
        o.x = pack2(v.x * (1.f + sc[i].x) + sh[i].x, v.y * (1.f + sc[i].y) + sh[i].y);
        o.y = pack2(v.z * (1.f + sc[i].z) + sh[i].z, v.w * (1.f + sc[i].w) + sh[i].w);
        *(uint2*)(p.H + (size_t)rr * 1024 + i * 256 + lane * 4) = o;
      }
    }
  }
}

template <int EPI>
DI bool tile_coords(int j, int mpx, int& m0, int& n0) {
  const int x = blockIdx.x & 7, s = blockIdx.x >> 3, ns = gridDim.x >> 3;
  const int q = s + ns * j;
  if constexpr (EPI == 0) {
    if (q >= mpx * 15) return false;
    const int panel = q / 90, i = q % 90;
    const int nt = i / 6, mi = i % 6;
    m0 = (x * mpx + panel * 6 + mi) * 256;
    n0 = nt * 256;
  } else {
    if (q >= mpx * 4) return false;
    m0 = (x * mpx + (q >> 2)) * 256;
    n0 = (q & 3) * 256;
  }
  return true;
}

template <int EPI>
DI void gemm_phase(const P& p, int l, const u16* __restrict__ A, const u16* __restrict__ Bt, int mpx, char* lds) {
  const int tid = tidx();
  int t = 0;
  int m0, n0;
  if (!tile_coords<EPI>(t, mpx, m0, n0)) return;
  const unsigned voffb = (unsigned)(((tid >> 3) * 1024 + (tid & 7) * 8) * 2);
  const u16* Ag = A + (size_t)m0 * 1024;
  const u16* Bg = Bt + (size_t)n0 * 1024;
  uint4 ra0, ra1, ra2, ra3, rb0, rb1, rb2, rb3;
#define GLOAD(AP, BP, k0)                                                       \
  ra0 = *(const uint4*)((const char*)((AP) + 0 * 64 * 1024 + (k0)) + voffb);   \
  ra1 = *(const uint4*)((const char*)((AP) + 1 * 64 * 1024 + (k0)) + voffb);   \
  ra2 = *(const uint4*)((const char*)((AP) + 2 * 64 * 1024 + (k0)) + voffb);   \
  ra3 = *(const uint4*)((const char*)((AP) + 3 * 64 * 1024 + (k0)) + voffb);   \
  rb0 = *(const uint4*)((const char*)((BP) + 0 * 64 * 1024 + (k0)) + voffb);   \
  rb1 = *(const uint4*)((const char*)((BP) + 1 * 64 * 1024 + (k0)) + voffb);   \
  rb2 = *(const uint4*)((const char*)((BP) + 2 * 64 * 1024 + (k0)) + voffb);   \
  rb3 = *(const uint4*)((const char*)((BP) + 3 * 64 * 1024 + (k0)) + voffb);
#define GSTORE(AS, BS)                       \
  *(uint4*)&(AS)[lw + 0 * 64 * 64] = ra0;    \
  *(uint4*)&(AS)[lw + 1 * 64 * 64] = ra1;    \
  *(uint4*)&(AS)[lw + 2 * 64 * 64] = ra2;    \
  *(uint4*)&(AS)[lw + 3 * 64 * 64] = ra3;    \
  *(uint4*)&(BS)[lw + 0 * 64 * 64] = rb0;    \
  *(uint4*)&(BS)[lw + 1 * 64 * 64] = rb1;    \
  *(uint4*)&(BS)[lw + 2 * 64 * 64] = rb2;    \
  *(uint4*)&(BS)[lw + 3 * 64 * 64] = rb3;
#define GCOMPUTE_KS(AS, BS, ks)                                                                                   \
  {                                                                                                               \
    bf16x8 bfr[4];                                                                                                \
    _Pragma("unroll") for (int ni = 0; ni < 4; ++ni) bfr[ni] = *(const bf16x8*)&(BS)[(wn * 64 + ni * 16 + r) * 64 + ((((ks) * 4 + g) ^ (r & 7)) * 8)]; \
    _Pragma("unroll") for (int mh = 0; mh < 2; ++mh) {                                                            \
      bf16x8 af[4];                                                                                               \
      _Pragma("unroll") for (int mi = 0; mi < 4; ++mi) af[mi] = *(const bf16x8*)&(AS)[(wm * 128 + (mh * 4 + mi) * 16 + r) * 64 + ((((ks) * 4 + g) ^ (r & 7)) * 8)];  \
      _Pragma("unroll") for (int mi = 0; mi < 4; ++mi)                                                            \
        _Pragma("unroll") for (int ni = 0; ni < 4; ++ni) acc[mh * 4 + mi][ni] = MFMA(af[mi], bfr[ni], acc[mh * 4 + mi][ni]);  \
    }                                                                                                             \
  }
#define GCOMPUTE(AS, BS) GCOMPUTE_KS(AS, BS, 0) GCOMPUTE_KS(AS, BS, 1)
  GLOAD(Ag, Bg, 0)
  u16* As0 = (u16*)lds;
  u16* Bs0 = As0 + 256 * 64;
  u16* As1 = Bs0 + 256 * 64;
  u16* Bs1 = As1 + 256 * 64;
  const int lw = (tid >> 3) * 64 + (((tid & 7) ^ ((tid >> 3) & 7)) * 8);
  GSTORE(As0, Bs0)
  while (true) {
  const int tn = t + 1;
  int m1 = 0, n1 = 0;
  const bool has_next = tile_coords<EPI>(tn, mpx, m1, n1);
  const u16* Agn = A + (size_t)m1 * 1024;
  const u16* Bgn = Bt + (size_t)n1 * 1024;
  f32x4 acc[8][4];
#pragma unroll
  for (int i = 0; i < 8; ++i)
#pragma unroll
    for (int j = 0; j < 4; ++j) acc[i][j] = zero4();
  {
  const int lane = tid & 63, w = tid >> 6, r = lane & 15, g = lane >> 4, wm = w >> 2, wn = w & 3;
  __syncthreads();
  GLOAD(Ag, Bg, 64)
  __builtin_amdgcn_sched_barrier(0);
  GCOMPUTE_KS(As0, Bs0, 0)
  __builtin_amdgcn_sched_barrier(0);
  GSTORE(As1, Bs1)
  GLOAD(Ag, Bg, 128)
  __builtin_amdgcn_sched_barrier(0);
  GCOMPUTE_KS(As0, Bs0, 1)
  __builtin_amdgcn_sched_barrier(0);
#pragma unroll 1
  for (int kk = 1; kk < 15; kk += 2) {
    __syncthreads();
    GSTORE(As0, Bs0)
    GLOAD(Ag, Bg, (kk + 2) * 64)
    __builtin_amdgcn_sched_barrier(0);
    GCOMPUTE(As1, Bs1)
    __builtin_amdgcn_sched_barrier(0);
    __syncthreads();
    GSTORE(As1, Bs1)
    {
      const bool in_tile = kk + 3 < 16;
      const u16* pa = in_tile ? Ag : Agn;
      const u16* pb = in_tile ? Bg : Bgn;
      const int k0 = in_tile ? (kk + 3) * 64 : 0;
      GLOAD(pa, pb, k0)
    }
    __builtin_amdgcn_sched_barrier(0);
    GCOMPUTE(As0, Bs0)
    __builtin_amdgcn_sched_barrier(0);
  }
  __syncthreads();
  __builtin_amdgcn_sched_barrier(0);
  GCOMPUTE(As1, Bs1)
  __builtin_amdgcn_sched_barrier(0);
  }
  __syncthreads();
  GSTORE(As0, Bs0)
  const int tid_e = tidx();
  const int lane = tid_e & 63, w = tid_e >> 6, r = lane & 15, g = lane >> 4, wm = w >> 2, wn = w & 3;
  if constexpr (EPI == 1) {
    const float alpha = 1.4142135623730951f;
    float* Cw = (float*)(lds + 65536) + w * (16 * 68);
    const int mr = m0 < MLAT ? (m0 >> 11) : 16;
    const int colw = n0 + wn * 64;
    const float* gate = p.mod + (size_t)(l * 17 + mr) * 3072 + 2048 + colw;
    const float* xr = ((l == 0) ? (m0 < MLAT ? p.x + (size_t)m0 * 1024 : p.ctx + (size_t)(m0 - MLAT) * 1024)
                                : p.out + (size_t)m0 * 1024) + (size_t)(wm * 128) * 1024 + colw;
    float* Z = (float*)p.slab + (size_t)(m0 + wm * 128) * 1024 + colw;
    const int c4 = (lane & 15) * 4, rr0 = lane >> 4;
    const float4 gt = *(const float4*)(gate + c4);
    float4 xn[4];
#pragma unroll
    for (int i = 0; i < 4; ++i) xn[i] = *(const float4*)(xr + (size_t)(rr0 + 4 * i) * 1024 + c4);
#pragma unroll
    for (int mi = 0; mi < 8; ++mi) {
      float4 xv[4];
#pragma unroll
      for (int i = 0; i < 4; ++i) xv[i] = xn[i];
      if (mi < 7) {
#pragma unroll
        for (int i = 0; i < 4; ++i) xn[i] = *(const float4*)(xr + (size_t)((mi + 1) * 16 + rr0 + 4 * i) * 1024 + c4);
      }
#pragma unroll
      for (int ni = 0; ni < 4; ++ni)
#pragma unroll
        for (int j = 0; j < 4; ++j) Cw[(g * 4 + j) * 68 + ni * 16 + r] = acc[mi][ni][j];
      __builtin_amdgcn_fence(__ATOMIC_RELEASE, "wavefront");
#pragma unroll
      for (int i = 0; i < 4; ++i) {
        const int row = rr0 + 4 * i;
        const float4 a = *(const float4*)&Cw[row * 68 + c4];
        float4 z;
        z.x = alpha * xv[i].x + gt.x * a.x;
        z.y = alpha * xv[i].y + gt.y * a.y;
        z.z = alpha * xv[i].z + gt.z * a.z;
        z.w = alpha * xv[i].w + gt.w * a.w;
        *(float4*)(Z + (size_t)(mi * 16 + row) * 1024 + c4) = z;
      }
      __builtin_amdgcn_fence(__ATOMIC_RELEASE, "wavefront");
    }
  } else {
    const int cb = n0 + wn * 64;
    const bool isctx = m0 >= MLAT;
    const int b = isctx ? ((m0 - MLAT) >> 8) : (m0 >> 11);
    const int tokw = (isctx ? 2048 + ((m0 - MLAT) & 255) : (m0 & 2047)) + wm * 128;
    u16* Tl = (u16*)(lds + 65536) + w * (64 * 72);
    int kind = 0;
    int tr = 0;
    bool donorm = false;
    if (cb >= 2816) { kind = 2; tr = 1; }
    else if (cb < 256) tr = 1;
    else if (cb < 512) tr = 0;
    else if (cb < 1024) tr = 2;
    else if (cb < 1408) { tr = 3; donorm = true; }
    else if (cb < 1536) kind = 1;
    else if (cb < 2048) tr = isctx ? 0 : 4;
    else if (cb < 2304) kind = 1;
    else if (cb < 2688) tr = isctx ? 0 : 3;
    else kind = 1;
    const float* gw = (cb < 1280 ? p.ga_qn : p.ga_kn) + l * 64;
    float gv0 = 1.f, gv1 = 1.f, gv2 = 1.f, gv3 = 1.f;
    if (donorm) { gv0 = gw[r]; gv1 = gw[16 + r]; gv2 = gw[32 + r]; gv3 = gw[48 + r]; }
    const bool dorope = (tr == 3) && !isctx;
    const float invf64 = exp2f(-13.287712379549449f * (float)r * (1.f / 16.f));
    const float invf32 = exp2f(-13.287712379549449f * (float)(r & 7) * (1.f / 8.f));
    const bool lo8 = r < 8;
    u16* dst;
    size_t rstride;
    if (kind == 2) {
      dst = p.G + (size_t)(m0 + wm * 128) * 1024 + (cb - 2816);
      rstride = 1024;
    } else if (kind == 1) {
      dst = slab_ptr(p, cb >> 6, b) + tokw;
      rstride = T;
    } else {
      dst = slab_ptr(p, cb >> 6, b) + (size_t)tokw * 64;
      rstride = 64;
    }
#pragma unroll
    for (int hf = 0; hf < 2; ++hf) {
#pragma unroll
      for (int mi = 0; mi < 4; ++mi) {
#pragma unroll
        for (int j = 0; j < 4; ++j) {
          float v0 = acc[hf * 4 + mi][0][j], v1 = acc[hf * 4 + mi][1][j], v2 = acc[hf * 4 + mi][2][j], v3 = acc[hf * 4 + mi][3][j];
          const int rowl = mi * 16 + g * 4 + j;
          const int s = tokw + hf * 64 + rowl;
          if (tr == 1) {
            v0 = silu(v0); v1 = silu(v1); v2 = silu(v2); v3 = silu(v3);
          } else if (tr == 3) {
            if (donorm) {
              float ss = v0 * v0 + v1 * v1 + v2 * v2 + v3 * v3;
              ss += __shfl_xor(ss, 1);
              ss += __shfl_xor(ss, 2);
              ss += __shfl_xor(ss, 4);
              ss += __shfl_xor(ss, 8);
              const float inv = rsqrtf(ss * (1.f / 64.f) + 1e-6f);
              v0 *= inv * gv0; v1 *= inv * gv1; v2 *= inv * gv2; v3 *= inv * gv3;
            }
            if (dorope) {
              float sr, cr, sc, cc;
              sincos_rev((float)(s >> 6) * invf64, sr, cr);
              sincos_rev((float)(s & 63) * invf64, sc, cc);
              const float a1 = v0, a2 = v1, b1 = v2, b2 = v3;
              v0 = a1 * cr - a2 * sr;
              v1 = a2 * cr + a1 * sr;
              v2 = b1 * cc - b2 * sc;
              v3 = b2 * cc + b1 * sc;
            }
          } else if (tr == 4) {
            float sr, cr, sc, cc;
            sincos_rev((float)(s >> 6) * invf32, sr, cr);
            sincos_rev((float)(s & 63) * invf32, sc, cc);
            const float p0 = __shfl_xor(v0, 8), p1 = __shfl_xor(v1, 8), p2 = __shfl_xor(v2, 8), p3 = __shfl_xor(v3, 8);
            v0 = lo8 ? (v0 * cr - p0 * sr) : (v0 * cr + p0 * sr);
            v1 = lo8 ? (v1 * cc - p1 * sc) : (v1 * cc + p1 * sc);
            v2 = lo8 ? (v2 * cr - p2 * sr) : (v2 * cr + p2 * sr);
            v3 = lo8 ? (v3 * cc - p3 * sc) : (v3 * cc + p3 * sc);
          }
          const unsigned u01 = pack2(v0, v1), u23 = pack2(v2, v3);
          if (kind == 1) {
            Tl[(0 * 16 + r) * 72 + rowl] = (u16)u01;
            Tl[(1 * 16 + r) * 72 + rowl] = (u16)(u01 >> 16);
            Tl[(2 * 16 + r) * 72 + rowl] = (u16)u23;
            Tl[(3 * 16 + r) * 72 + rowl] = (u16)(u23 >> 16);
          } else if (tr == 2) {
            Tl[rowl * 72 + 0 * 16 + r] = f2h(v0);
            Tl[rowl * 72 + 1 * 16 + r] = f2h(v1);
            Tl[rowl * 72 + 2 * 16 + r] = f2h(v2);
            Tl[rowl * 72 + 3 * 16 + r] = f2h(v3);
          } else {
            Tl[rowl * 72 + 0 * 16 + r] = (u16)u01;
            Tl[rowl * 72 + 1 * 16 + r] = (u16)(u01 >> 16);
            Tl[rowl * 72 + 2 * 16 + r] = (u16)u23;
            Tl[rowl * 72 + 3 * 16 + r] = (u16)(u23 >> 16);
          }
        }
      }
      __builtin_amdgcn_fence(__ATOMIC_RELEASE, "wavefront");
      u16* dh = (kind == 1) ? dst + hf * 64 : dst + (size_t)(hf * 64) * rstride;
#pragma unroll
      for (int i = 0; i < 8; ++i) {
        const int c = lane + i * 64;
        const int row = c >> 3, cc = c & 7;
        uint4 v = *(const uint4*)&Tl[row * 72 + cc * 8];
        *(uint4*)(dh + (size_t)row * rstride + cc * 8) = v;
      }
      __builtin_amdgcn_fence(__ATOMIC_RELEASE, "wavefront");
    }
  }
  if (!has_next) break;
  t = tn; m0 = m1; n0 = n1; Ag = Agn; Bg = Bgn;
  }
}

DI void phase_inproj(const P& p, int l, char* lds) {
  gemm_phase<0>(p, l, p.H, p.Wt + (size_t)l * NIN * 1024, (MALL / 256) / 8, lds);
}
DI void phase_outproj(const P& p, int l, char* lds) {
  const int mrows = (l == 0) ? MALL : MLAT;
  gemm_phase<1>(p, l, p.H  , p.Wot + (size_t)l * 1024 * 1024, (mrows / 256) / 8, lds);
}

template <int MODE>
DI void attn_item(const P& p, const u16* __restrict__ Q0, const u16* __restrict__ Q1, const u16* __restrict__ Kp,
                  const u16* __restrict__ Vp, int qtok0, int ka0, int na, int kb0, int nb, bool window, float c1, bool has_sink,
                  float sink0, float sink1, int yrow0, int ycol0, float lam, const float* __restrict__ subln, float outscale,
                  char* lds) {
  const int tid = tidx(), lane = tid & 63, w = tid >> 6, r = lane & 15, g = lane >> 4;
  u16* Kbase = (u16*)lds;
  bf16x8 qf[2][2][2];
#pragma unroll
  for (int tt = 0; tt < 2; ++tt)
#pragma unroll
    for (int hh = 0; hh < 2; ++hh) {
      const int tok = qtok0 + w * 32 + tt * 16 + r;
      const u16* base = (hh ? Q1 : Q0) + (size_t)tok * 64;
      if constexpr (MODE == 0) {
        qf[tt][hh][0] = *(const bf16x8*)(base + g * 8);
        qf[tt][hh][1] = *(const bf16x8*)(base + 32 + g * 8);
      } else {
        qf[tt][hh][0] = *(const bf16x8*)(base + hh * 32 + g * 8);
        qf[tt][hh][1] = qf[tt][hh][0];
      }
    }
  f32x4 O[2][2][4];
  float lsum[2][2], nbias[2][2];
  bool first = true;
#pragma unroll
  for (int tt = 0; tt < 2; ++tt)
#pragma unroll
    for (int hh = 0; hh < 2; ++hh) {
      lsum[tt][hh] = 0.f;
      nbias[tt][hh] = 0.f;
#pragma unroll
      for (int dt = 0; dt < 4; ++dt) O[tt][hh][dt] = zero4();
    }
  const int ntile = na + nb;
  const int lrow = tid >> 3, lcc = (tid & 7) * 8;
  const unsigned kvoff = (unsigned)((lrow * 64 + lcc) * 2), vvoff = (unsigned)((lrow * T + lcc) * 2);
  const int krow = (lrow & 32) | (((lrow >> 2) & 1) * 16) | (((lrow >> 3) & 3) * 4) | (lrow & 3);
  const int kwoff = krow * 64 + (((tid & 7) ^ (krow & 7)) * 8);
  const int vwoff = lrow * 64 + (((tid & 7) ^ (lrow & 7)) * 8);
  uint4 kr0, vr0;
#define ALOAD(kt)                                                          \
  kr0 = *(const uint4*)((const char*)(Kp + (size_t)(kt) * 64) + kvoff);     \
  vr0 = *(const uint4*)((const char*)(Vp + (kt)) + vvoff);
  {
    const int kt0 = (0 < na) ? ka0 : kb0;
    ALOAD(kt0)
  }
  __syncthreads();
  *(uint4*)&Kbase[kwoff] = kr0;
  *(uint4*)&Kbase[64 * 64 + vwoff] = vr0;
  for (int it = 0; it < ntile; ++it) {
    const int kt0 = (it < na) ? ka0 + it * 64 : kb0 + (it - na) * 64;
    const bool masked = window && (it < na);
    const u16* Ks = Kbase + (it & 1) * (2 * 64 * 64);
    const u16* Vs = Ks + 64 * 64;
    __syncthreads();
    const bool more = it + 1 < ntile;
    if (more) {
      const int kn = (it + 1 < na) ? ka0 + (it + 1) * 64 : kb0 + (it + 1 - na) * 64;
      ALOAD(kn)
    }
    bool skip = false;
    if (masked) {
      const int qlo = qtok0 + __builtin_amdgcn_readfirstlane(w) * 32;
      skip = (kt0 > qlo + 31 + 128) || (kt0 + 63 < qlo - 128);
    }
    if (!skip) {
    f32x4 S[2][2][2][2];
#pragma unroll
    for (int kh = 0; kh < 2; ++kh) {
      bf16x8 kf[2][2];
#pragma unroll
      for (int t = 0; t < 2; ++t)
#pragma unroll
        for (int s2 = 0; s2 < 2; ++s2)
          kf[t][s2] = *(const bf16x8*)&Ks[(kh * 32 + t * 16 + r) * 64 + (((s2 * 4 + g) ^ (r & 7)) * 8)];
#pragma unroll
      for (int tt = 0; tt < 2; ++tt)
#pragma unroll
        for (int hh = 0; hh < 2; ++hh) {
          f32x4 s0 = zero4(), s1 = zero4();
          if constexpr (MODE == 0) {
            s0 = MFMA(kf[0][0], qf[tt][hh][0], s0);
            s1 = MFMA(kf[1][0], qf[tt][hh][0], s1);
            s0 = MFMA(kf[0][1], qf[tt][hh][1], s0);
            s1 = MFMA(kf[1][1], qf[tt][hh][1], s1);
          } else {
            s0 = MFMA(kf[0][hh], qf[tt][hh][0], s0);
            s1 = MFMA(kf[1][hh], qf[tt][hh][0], s1);
          }
          S[kh][tt][hh][0] = s0;
          S[kh][tt][hh][1] = s1;
        }
    }
    if (masked) {
#pragma unroll
      for (int kh = 0; kh < 2; ++kh)
#pragma unroll
        for (int tt = 0; tt < 2; ++tt) {
          const int qpos = qtok0 + w * 32 + tt * 16 + r;
          const int kp0 = kt0 + kh * 32 + g * 8;
#pragma unroll
          for (int t = 0; t < 2; ++t)
#pragma unroll
            for (int j = 0; j < 4; ++j) {
              int d = kp0 + t * 4 + j - qpos;
              d = d < 0 ? -d : d;
              if (d > 128) { S[kh][tt][0][t][j] = -INFINITY; S[kh][tt][1][t][j] = -INFINITY; }
            }
        }
    }
#pragma unroll
    for (int tt = 0; tt < 2; ++tt)
#pragma unroll
      for (int hh = 0; hh < 2; ++hh) {
        const float nb = nbias[tt][hh];
#pragma unroll
        for (int kh = 0; kh < 2; ++kh)
#pragma unroll
          for (int t = 0; t < 2; ++t) S[kh][tt][hh][t] = S[kh][tt][hh][t] * c1 + nb;
      }
    {
      float mxq[2][2];
      bool need = first;
#pragma unroll
      for (int tt = 0; tt < 2; ++tt)
#pragma unroll
        for (int hh = 0; hh < 2; ++hh) {
          const float m0 = fmaxf(fmaxf(S[0][tt][hh][0][0], S[0][tt][hh][0][1]), S[0][tt][hh][0][2]);
          const float m1 = fmaxf(fmaxf(S[0][tt][hh][1][0], S[0][tt][hh][1][1]), S[0][tt][hh][1][2]);
          const float m2 = fmaxf(fmaxf(S[1][tt][hh][0][0], S[1][tt][hh][0][1]), S[1][tt][hh][0][2]);
          const float m3 = fmaxf(fmaxf(S[1][tt][hh][1][0], S[1][tt][hh][1][1]), S[1][tt][hh][1][2]);
          const float m4 = fmaxf(fmaxf(S[0][tt][hh][0][3], S[0][tt][hh][1][3]), m0);
          const float m5 = fmaxf(fmaxf(S[1][tt][hh][0][3], S[1][tt][hh][1][3]), m1);
          mxq[tt][hh] = fmaxf(fmaxf(m2, m3), fmaxf(m4, m5));
          need = need || (mxq[tt][hh] > 8.f);
        }
      if (__builtin_amdgcn_ballot_w64(need) != 0) {
#pragma unroll
        for (int tt = 0; tt < 2; ++tt)
#pragma unroll
          for (int hh = 0; hh < 2; ++hh) {
            float mx = mxq[tt][hh];
            mx = fmaxf(mx, __shfl_xor(mx, 16));
            mx = fmaxf(mx, __shfl_xor(mx, 32));
            const float d = (mx == -INFINITY) ? 0.f : (first ? mx : fmaxf(mx, 0.f));
            const float alpha = __builtin_amdgcn_exp2f(-d);
            lsum[tt][hh] *= alpha;
            nbias[tt][hh] -= d;
#pragma unroll
            for (int dt = 0; dt < 4; ++dt)
#pragma unroll
              for (int j = 0; j < 4; ++j) O[tt][hh][dt][j] *= alpha;
#pragma unroll
            for (int kh = 0; kh < 2; ++kh)
#pragma unroll
              for (int t = 0; t < 2; ++t) S[kh][tt][hh][t] = S[kh][tt][hh][t] - d;
          }
      }
      first = false;
    }
#pragma unroll
    for (int kh = 0; kh < 2; ++kh) {
#pragma unroll
      for (int tt = 0; tt < 2; ++tt) {
        bf16x8 pf[2];
#pragma unroll
        for (int hh = 0; hh < 2; ++hh) {
          float pv[8];
#pragma unroll
          for (int j = 0; j < 4; ++j) {
            pv[j] = __builtin_amdgcn_exp2f(S[kh][tt][hh][0][j]);
            pv[4 + j] = __builtin_amdgcn_exp2f(S[kh][tt][hh][1][j]);
          }
          lsum[tt][hh] += ((pv[0] + pv[1]) + (pv[2] + pv[3])) + ((pv[4] + pv[5]) + (pv[6] + pv[7]));
          const uint4 pk = make_uint4(pack2(pv[0], pv[1]), pack2(pv[2], pv[3]), pack2(pv[4], pv[5]), pack2(pv[6], pv[7]));
          pf[hh] = __builtin_bit_cast(bf16x8, pk);
        }
#pragma unroll
        for (int dt = 0; dt < 4; ++dt) {
          const bf16x8 vf = *(const bf16x8*)&Vs[(dt * 16 + r) * 64 + (((kh * 4 + g) ^ (r & 7)) * 8)];
          O[tt][0][dt] = MFMA(vf, pf[0], O[tt][0][dt]);
          O[tt][1][dt] = MFMA(vf, pf[1], O[tt][1][dt]);
        }
      }
    }
    }
    if (more) {
      u16* Kn = Kbase + ((it + 1) & 1) * (2 * 64 * 64);
      *(uint4*)&Kn[kwoff] = kr0;
      *(uint4*)&Kn[64 * 64 + vwoff] = vr0;
    }
  }
  float linv[2][2];
#pragma unroll
  for (int tt = 0; tt < 2; ++tt)
#pragma unroll
    for (int hh = 0; hh < 2; ++hh) {
      float lt = lsum[tt][hh];
      lt += __shfl_xor(lt, 16);
      lt += __shfl_xor(lt, 32);
      if (has_sink) lt += __builtin_amdgcn_exp2f((hh ? sink1 : sink0) + nbias[tt][hh]);
      linv[tt][hh] = 1.f / lt;
    }
  if constexpr (MODE == 0) {
    uint2 gg[2][2][4];
#pragma unroll
    for (int tt = 0; tt < 2; ++tt)
#pragma unroll
      for (int hh = 0; hh < 2; ++hh)
#pragma unroll
        for (int dt = 0; dt < 4; ++dt)
          gg[tt][hh][dt] = *(const uint2*)(p.G + (size_t)(yrow0 + w * 32 + tt * 16 + r) * 1024 + ycol0 + hh * 64 + dt * 16 + g * 4);
#pragma unroll
    for (int tt = 0; tt < 2; ++tt) {
      const int row = yrow0 + w * 32 + tt * 16 + r;
#pragma unroll
      for (int hh = 0; hh < 2; ++hh)
#pragma unroll
        for (int dt = 0; dt < 4; ++dt) {
          const int col = ycol0 + hh * 64 + dt * 16 + g * 4;
          const float li = linv[tt][hh];
          const uint2 gq = gg[tt][hh][dt];
          uint2 o;
          o.x = pack2(O[tt][hh][dt][0] * li * bflo(gq.x), O[tt][hh][dt][1] * li * bfhi(gq.x));
          o.y = pack2(O[tt][hh][dt][2] * li * bflo(gq.y), O[tt][hh][dt][3] * li * bfhi(gq.y));
          *(uint2*)(p.H + (size_t)row * 1024 + col) = o;
        }
    }
  } else {
    uint2 gg[2][4];
    float4 sgv[4];
#pragma unroll
    for (int dt = 0; dt < 4; ++dt) sgv[dt] = *(const float4*)(subln + dt * 16 + g * 4);
#pragma unroll
    for (int tt = 0; tt < 2; ++tt)
#pragma unroll
      for (int dt = 0; dt < 4; ++dt)
        gg[tt][dt] = *(const uint2*)(p.G + (size_t)(yrow0 + w * 32 + tt * 16 + r) * 1024 + ycol0 + dt * 16 + g * 4);
#pragma unroll
    for (int tt = 0; tt < 2; ++tt) {
      const int row = yrow0 + w * 32 + tt * 16 + r;
      float ov[4][4];
      float ss = 0.f;
#pragma unroll
      for (int dt = 0; dt < 4; ++dt)
#pragma unroll
        for (int j = 0; j < 4; ++j) {
          const float v = O[tt][0][dt][j] * linv[tt][0] - lam * O[tt][1][dt][j] * linv[tt][1];
          ov[dt][j] = v;
          ss += v * v;
        }
      ss += __shfl_xor(ss, 16);
      ss += __shfl_xor(ss, 32);
      const float rinv = rsqrtf(ss * (1.f / 64.f) + 1e-6f) * outscale;
#pragma unroll
      for (int dt = 0; dt < 4; ++dt) {
        const int col = ycol0 + dt * 16 + g * 4;
        const uint2 gq = gg[tt][dt];
        const float4 sg = sgv[dt];
        uint2 o;
        o.x = pack2(ov[dt][0] * rinv * sg.x * bflo(gq.x), ov[dt][1] * rinv * sg.y * bfhi(gq.x));
        o.y = pack2(ov[dt][2] * rinv * sg.z * bflo(gq.y), ov[dt][3] * rinv * sg.w * bfhi(gq.y));
        *(uint2*)(p.H + (size_t)row * 1024 + col) = o;
      }
    }
  }
}

DI void hgrn_unit(const P& p, int l, int unit, char* lds_all) {
  const int tid512 = tidx();
  const int dir = tid512 >> 8;
  const int tid = tid512 & 255, lane = tid & 63, w = tid >> 6, r = lane & 15, g = lane >> 4;
  char* lds = lds_all + dir * 73728;
  const int b = unit >> 2, h = unit & 3;
  float* Lf = (float*)lds;
  float* Seg = Lf + 64 * 65;
  u16* Qm = (u16*)(Seg + 256);
  u16* Km = Qm + 64 * 72;
  u16* KmT = Km + 64 * 72;
  u16* Vt = KmT + 64 * 72;
  u16* Att = Vt + 64 * 72;
  u16* St = Att + 64 * 72;
  const u16* qs = slab_ptr(p, h, b);
  const u16* is = slab_ptr(p, 4 + h, b);
  const u16* zs = slab_ptr(p, 8 + dir * 4 + h, b);
  float* Og = (dir ? p.OB : p.OF) + (size_t)(b * 4 + h) * T * 64;
  const int tau = tid >> 2, kc = (tid & 3) * 16;
  float lbv[16];
#pragma unroll
  for (int i = 0; i < 16; ++i) {
    if (l == 0) {
      lbv[i] = 0.f;
    } else {
      const float e0 = p.lb_logits[(0 * 2 + dir) * 256 + h * 64 + kc + i];
      const float e1 = p.lb_logits[(1 * 2 + dir) * 256 + h * 64 + kc + i];
      lbv[i] = 1.f / (1.f + __expf(e0 - e1));
    }
  }
  f32x4 Sacc[4];
#pragma unroll
  for (int nt = 0; nt < 4; ++nt) Sacc[nt] = zero4();

  for (int c = 0; c < 36; ++c) {
    int base;
    if (c < 4) base = 2048 + (dir ? (3 - c) : c) * 64;
    else base = (dir ? (31 - (c - 4)) : (c - 4)) * 64;
    const int tok = base + (dir ? 63 - tau : tau);
    float qv[16], kk[16];
    {
      const uint4* qp = (const uint4*)(qs + (size_t)tok * 64 + kc);
      const uint4* zp = (const uint4*)(zs + (size_t)tok * 64 + kc);
      const uint4* vp = (const uint4*)(is + (size_t)tok * 64 + kc);
      const uint4 q0 = qp[0], q1 = qp[1], z0 = zp[0], z1 = zp[1], v0 = vp[0], v1 = vp[1];
      const unsigned qw[8] = {q0.x, q0.y, q0.z, q0.w, q1.x, q1.y, q1.z, q1.w};
      const unsigned zw[8] = {z0.x, z0.y, z0.z, z0.w, z1.x, z1.y, z1.z, z1.w};
      const unsigned vw[8] = {v0.x, v0.y, v0.z, v0.w, v1.x, v1.y, v1.z, v1.w};
#pragma unroll
      for (int e = 0; e < 8; ++e) {
        qv[2 * e] = bflo(qw[e]);
        qv[2 * e + 1] = bfhi(qw[e]);
        const float za = hflo(zw[e]), zb = hfhi(zw[e]);
        const float fa = lbv[2 * e] + (1.f - lbv[2 * e]) / (1.f + __expf(-za));
        const float fb = lbv[2 * e + 1] + (1.f - lbv[2 * e + 1]) / (1.f + __expf(-zb));
        kk[2 * e] = 1.f - fa;
        kk[2 * e + 1] = 1.f - fb;
        Lf[tau * 65 + kc + 2 * e] = __logf(fa);
        Lf[tau * 65 + kc + 2 * e + 1] = __logf(fb);
        Vt[(kc + 2 * e) * 72 + tau] = (u16)(vw[e] & 0xffffu);
        Vt[(kc + 2 * e + 1) * 72 + tau] = (u16)(vw[e] >> 16);
      }
    }
    __syncthreads();
    {
      const int k = tid & 63, sg = tid >> 6;
      float run = 0.f;
#pragma unroll
      for (int i = 0; i < 16; ++i) {
        float* ptr = &Lf[(sg * 16 + i) * 65 + k];
        run += *ptr;
        *ptr = run;
      }
      Seg[sg * 64 + k] = run;
    }
    __syncthreads();
    {
      const int sg = tau >> 4;
      unsigned qmw[8], kmw[8];
#pragma unroll
      for (int e = 0; e < 8; ++e) {
        float qq[2], km2[2];
#pragma unroll
        for (int u = 0; u < 2; ++u) {
          const int i = 2 * e + u, k = kc + i;
          const float s0 = Seg[k], s1 = Seg[64 + k], s2 = Seg[128 + k];
          const float off = (sg > 0 ? s0 : 0.f) + (sg > 1 ? s1 : 0.f) + (sg > 2 ? s2 : 0.f);
          const float bc = Lf[tau * 65 + k] + off;
          const float rr = Lf[31 * 65 + k] + s0;
          qq[u] = qv[i] * __expf(bc - rr);
          km2[u] = kk[i] * __expf(rr - bc);
          KmT[k * 72 + tau] = f2bf(km2[u]);
        }
        qmw[e] = pack2(qq[0], qq[1]);
        kmw[e] = pack2(km2[0], km2[1]);
      }
      *(uint4*)&Qm[tau * 72 + kc] = make_uint4(qmw[0], qmw[1], qmw[2], qmw[3]);
      *(uint4*)&Qm[tau * 72 + kc + 8] = make_uint4(qmw[4], qmw[5], qmw[6], qmw[7]);
      *(uint4*)&Km[tau * 72 + kc] = make_uint4(kmw[0], kmw[1], kmw[2], kmw[3]);
      *(uint4*)&Km[tau * 72 + kc + 8] = make_uint4(kmw[4], kmw[5], kmw[6], kmw[7]);
#pragma unroll
      for (int nt = 0; nt < 4; ++nt) {
        const int k = nt * 16 + r;
        const float er = __expf(Lf[31 * 65 + k] + Seg[k]);
#pragma unroll
        for (int j = 0; j < 4; ++j) St[(w * 16 + g * 4 + j) * 72 + k] = f2bf(Sacc[nt][j] * er);
      }
    }
    __syncthreads();
    bf16x8 aq[2];
#pragma unroll
    for (int ks = 0; ks < 2; ++ks) aq[ks] = *(const bf16x8*)&Qm[(w * 16 + r) * 72 + ks * 32 + g * 8];
    f32x4 oacc[4];
#pragma unroll
    for (int nt = 0; nt < 4; ++nt) {
      f32x4 a = zero4();
#pragma unroll
      for (int ks = 0; ks < 2; ++ks) {
        const bf16x8 bk = *(const bf16x8*)&Km[(nt * 16 + r) * 72 + ks * 32 + g * 8];
        a = MFMA(aq[ks], bk, a);
      }
#pragma unroll
      for (int j = 0; j < 4; ++j) {
        const bool keep = (nt * 16 + r) <= (w * 16 + g * 4 + j);
        const float v = keep ? a[j] : 0.f;
        Att[(w * 16 + g * 4 + j) * 72 + nt * 16 + r] = f2bf(v);
      }
    }
#pragma unroll
    for (int nt = 0; nt < 4; ++nt) {
      f32x4 a = zero4();
#pragma unroll
      for (int ks = 0; ks < 2; ++ks) {
        const bf16x8 bs = *(const bf16x8*)&St[(nt * 16 + r) * 72 + ks * 32 + g * 8];
        a = MFMA(aq[ks], bs, a);
      }
      oacc[nt] = a;
    }
    __syncthreads();
    bf16x8 aa[2], av[2];
#pragma unroll
    for (int ks = 0; ks < 2; ++ks) {
      aa[ks] = *(const bf16x8*)&Att[(w * 16 + r) * 72 + ks * 32 + g * 8];
      av[ks] = *(const bf16x8*)&Vt[(w * 16 + r) * 72 + ks * 32 + g * 8];
    }
#pragma unroll
    for (int nt = 0; nt < 4; ++nt) {
#pragma unroll
      for (int ks = 0; ks < 2; ++ks) {
        const bf16x8 bv = *(const bf16x8*)&Vt[(nt * 16 + r) * 72 + ks * 32 + g * 8];
        oacc[nt] = MFMA(aa[ks], bv, oacc[nt]);
      }
#pragma unroll
      for (int j = 0; j < 4; ++j) {
        const int t = w * 16 + g * 4 + j;
        const int tk = base + (dir ? 63 - t : t);
        Og[(size_t)tk * 64 + nt * 16 + r] = oacc[nt][j];
      }
    }
#pragma unroll
    for (int nt = 0; nt < 4; ++nt) {
      f32x4 u = zero4();
#pragma unroll
      for (int ks = 0; ks < 2; ++ks) {
        const bf16x8 bk = *(const bf16x8*)&KmT[(nt * 16 + r) * 72 + ks * 32 + g * 8];
        u = MFMA(av[ks], bk, u);
      }
      const int k = nt * 16 + r;
      const float s0 = Seg[k], s1 = Seg[64 + k], s2 = Seg[128 + k], s3 = Seg[192 + k];
      const float blast = s0 + s1 + s2 + s3;
      const float rk = Lf[31 * 65 + k] + s0;
      const float e1 = __expf(blast), e2 = __expf(blast - rk);
#pragma unroll
      for (int j = 0; j < 4; ++j) Sacc[nt][j] = e1 * Sacc[nt][j] + e2 * u[j];
    }
    __syncthreads();
  }
  __threadfence();
  __syncthreads();
  {
    const float* of = p.OF + (size_t)(b * 4 + h) * T * 64;
    const float* ob = p.OB + (size_t)(b * 4 + h) * T * 64;
    const float* ng = p.hg_norm_g + l * 64;
    const int ntok = (l == 0) ? T : SEQ;
    for (int idx0 = tid512; idx0 < ntok * 16; idx0 += 4 * NT) {
      float4 a4[4], b4[4];
      uint2 g4[4];
#pragma unroll
      for (int u = 0; u < 4; ++u) {
        const int idx = idx0 + u * NT;
        const int tok = idx >> 4, dv4 = idx & 15;
        const int row = tok < 2048 ? b * 2048 + tok : MLAT + b * 256 + (tok - 2048);
        a4[u] = *(const float4*)(of + (size_t)tok * 64 + dv4 * 4);
        b4[u] = *(const float4*)(ob + (size_t)tok * 64 + dv4 * 4);
        g4[u] = *(const uint2*)(p.G + (size_t)row * 1024 + h * 64 + dv4 * 4);
      }
#pragma unroll
      for (int u = 0; u < 4; ++u) {
        const int idx = idx0 + u * NT;
        const int tok = idx >> 4, dv4 = idx & 15;
        const float o0 = a4[u].x + b4[u].x, o1 = a4[u].y + b4[u].y, o2 = a4[u].z + b4[u].z, o3 = a4[u].w + b4[u].w;
        float ss = o0 * o0 + o1 * o1 + o2 * o2 + o3 * o3;
        ss += __shfl_xor(ss, 1);
        ss += __shfl_xor(ss, 2);
        ss += __shfl_xor(ss, 4);
        ss += __shfl_xor(ss, 8);
        const float rinv = rsqrtf(ss * (1.f / 64.f) + 1e-6f);
        const int row = tok < 2048 ? b * 2048 + tok : MLAT + b * 256 + (tok - 2048);
        const int col = h * 64 + dv4 * 4;
        const float4 n4 = *(const float4*)(ng + dv4 * 4);
        uint2 o;
        o.x = pack2(o0 * rinv * n4.x * bflo(g4[u].x), o1 * rinv * n4.y * bfhi(g4[u].x));
        o.y = pack2(o2 * rinv * n4.z * bflo(g4[u].y), o3 * rinv * n4.w * bfhi(g4[u].y));
        *(uint2*)(p.H + (size_t)row * 1024 + col) = o;
      }
    }
  }
  __syncthreads();
}

DI void phase_mix(const P& p, int l, int rep, char* lds) {
  __shared__ int s_item;
  const int nitems = 64 + 512 + 256 + 256 + (l == 0 ? 128 : 0);
  const float lam_init = (l == 0) ? 0.2f : (0.8f - 0.6f * 0.7408182206817179f);
  const float* dl = p.df_lam + l * 128;
  float d01 = 0.f, d23 = 0.f;
  for (int i = 0; i < 32; ++i) {
    d01 += dl[i] * dl[32 + i];
    d23 += dl[64 + i] * dl[96 + i];
  }
  const float lam = expf(d01) - expf(d23) + lam_init;
  const float* subln = p.df_subln + l * 64;
  const float cB = 0.125f * LOG2E, cC = 0.17677669529663687f * LOG2E;
  while (true) {
    if (tidx() == 0) s_item = atomicAdd(&p.ctr[l + 2 * rep], 1);
    __syncthreads();
    int it = __builtin_amdgcn_readfirstlane(s_item);
    __syncthreads();
    if (it >= nitems) break;
    if (it < 64) {
      hgrn_unit(p, l, it, lds);
      continue;
    }
    it -= 64;
    int mode, b, hq, qb, sq0, sq1, sk, sv, qtok0, ka0, na, kb0 = 2048, nb = 0, yrow0, ycol0;
    bool window = false, has_sink = false, isctx = false;
    int kind;
    if (it < 512) { kind = 0; b = it >> 5; hq = (it >> 3) & 3; qb = it & 7; }
    else if (it < 768) { it -= 512; kind = 1; b = it >> 4; hq = (it >> 3) & 1; qb = it & 7; }
    else if (it < 1024) { it -= 768; kind = 2; b = it >> 4; hq = (it >> 3) & 1; qb = it & 7; }
    else if (it < 1088) { it -= 1024; kind = 0; isctx = true; b = it >> 2; hq = it & 3; qb = 0; }
    else if (it < 1120) { it -= 1088; kind = 1; isctx = true; b = it >> 1; hq = it & 1; qb = 0; }
    else { it -= 1120; kind = 2; isctx = true; b = it >> 1; hq = it & 1; qb = 0; }
    if (kind == 0) { mode = 1; sq0 = 24 + hq; sq1 = sq0; sk = 28 + hq; sv = 32 + hq; ycol0 = 512 + hq * 64; }
    else if (kind == 1) { mode = 0; sq0 = 16 + hq * 2; sq1 = sq0 + 1; sk = 20 + hq; sv = 22 + hq; ycol0 = 256 + hq * 128; }
    else { mode = 0; sq0 = 36 + hq * 2; sq1 = sq0 + 1; sk = 40 + hq; sv = 42 + hq; ycol0 = 768 + hq * 128; has_sink = true; }
    if (isctx) {
      qtok0 = 2048; ka0 = 2048; na = 4; yrow0 = MLAT + b * 256;
    } else {
      qtok0 = qb * 256; yrow0 = b * 2048 + qb * 256;
      if (kind == 2) {
        window = true;
        ka0 = qtok0 - 128 < 0 ? 0 : qtok0 - 128;
        const int ka1 = qtok0 + 384 > 2048 ? 2048 : qtok0 + 384;
        na = (ka1 - ka0) >> 6; nb = 4;
      } else { ka0 = 0; na = 36; }
    }
    float sk0 = 0.f, sk1 = 0.f;
    if (has_sink) { sk0 = p.wn_sink[l * 4 + hq * 2] * LOG2E; sk1 = p.wn_sink[l * 4 + hq * 2 + 1] * LOG2E; }
    if (mode == 1)
      attn_item<1>(p, slab_ptr(p, sq0, b), slab_ptr(p, sq1, b), slab_ptr(p, sk, b), slab_ptr(p, sv, b), qtok0, ka0, na, kb0, nb, window,
                   cC, has_sink, sk0, sk1, yrow0, ycol0, lam, subln, 1.f - lam_init, lds);
    else
      attn_item<0>(p, slab_ptr(p, sq0, b), slab_ptr(p, sq1, b), slab_ptr(p, sk, b), slab_ptr(p, sv, b), qtok0, ka0, na, kb0, nb, window,
                   cB, has_sink, sk0, sk1, yrow0, ycol0, lam, subln, 1.f, lds);
  }
}

DI void phase_ln(const P& p, int l) {
  const int tid = tidx(); const int lane = tid & 63, w = tid >> 6;
  const int nrows = (l == 0) ? MALL : MLAT;
  const float* Zb = (const float*)p.slab;
  const float* lg = p.ln_g + l * 1024;
  const float* lb = p.ln_b + l * 1024;
  const int gw = blockIdx.x * 8 + w, nw = gridDim.x * 8;
  const int per = (nrows + nw - 1) / nw;
  const int r0 = gw * per, r1 = (r0 + per < nrows) ? r0 + per : nrows;
  float4 g4[4], b4[4];
#pragma unroll
  for (int i = 0; i < 4; ++i) {
    g4[i] = *(const float4*)(lg + i * 256 + lane * 4);
    b4[i] = *(const float4*)(lb + i * 256 + lane * 4);
  }
  for (int row = r0; row < r1; row += 2) {
    const bool two = row + 1 < r1;
    const int rowb = two ? row + 1 : row;
    float4 v[2][4];
#pragma unroll
    for (int i = 0; i < 4; ++i) {
      v[0][i] = *(const float4*)(Zb + (size_t)row * 1024 + i * 256 + lane * 4);
      v[1][i] = *(const float4*)(Zb + (size_t)rowb * 1024 + i * 256 + lane * 4);
    }
#pragma unroll
    for (int h = 0; h < 2; ++h) {
      if (h && !two) break;
      const int rr = h ? rowb : row;
      float s = 0.f;
#pragma unroll
      for (int i = 0; i < 4; ++i) s += (v[h][i].x + v[h][i].y) + (v[h][i].z + v[h][i].w);
#pragma unroll
      for (int o = 32; o >= 1; o >>= 1) s += __shfl_xor(s, o);
      const float mean = s * (1.f / 1024.f);
      float q = 0.f;
#pragma unroll
      for (int i = 0; i < 4; ++i) {
        v[h][i].x -= mean; v[h][i].y -= mean; v[h][i].z -= mean; v[h][i].w -= mean;
        q += (v[h][i].x * v[h][i].x + v[h][i].y * v[h][i].y) + (v[h][i].z * v[h][i].z + v[h][i].w * v[h][i].w);
      }
#pragma unroll
      for (int o = 32; o >= 1; o >>= 1) q += __shfl_xor(q, o);
      const float rstd = rsqrtf(q * (1.f / 1024.f) + 1e-5f);
      const int mr = rr < MLAT ? (rr >> 11) : 16;
      const float* md = p.mod + (size_t)(1 * 17 + mr) * 3072;
#pragma unroll
      for (int i = 0; i < 4; ++i) {
        const int col = i * 256 + lane * 4;
        float4 y;
        y.x = v[h][i].x * rstd * g4[i].x + b4[i].x;
        y.y = v[h][i].y * rstd * g4[i].y + b4[i].y;
        y.z = v[h][i].z * rstd * g4[i].z + b4[i].z;
        y.w = v[h][i].w * rstd * g4[i].w + b4[i].w;
        if (l == 1 || rr < MLAT) *(float4*)(p.out + (size_t)rr * 1024 + col) = y;
        if (l == 0) {
          const float4 sh = *(const float4*)(md + col), sc = *(const float4*)(md + 1024 + col);
          uint2 o;
          o.x = pack2(y.x * (1.f + sc.x) + sh.x, y.y * (1.f + sc.y) + sh.y);
          o.y = pack2(y.z * (1.f + sc.z) + sh.z, y.w * (1.f + sc.w) + sh.w);
          *(uint2*)(p.H + (size_t)rr * 1024 + col) = o;
        }
      }
    }
  }
}


#define XB_TMO      128
#define XB_XCNT(j)  (256  + 64 * (j))
#define XB_XSUB(j)  (1280 + 64 * (j))
#define XB_XGEN(j)  (2304 + 64 * (j))
#define XB_TOP      3328
#define XB_TOPGEN   3392
#define XCD_BAR_WORDS 3456
#define XB_SPIN_CAP (1u << 18)
#define LAS __attribute__((address_space(3)))

__device__ __forceinline__ unsigned xb_ld(unsigned* p)              { return __hip_atomic_load(p, __ATOMIC_RELAXED, __HIP_MEMORY_SCOPE_AGENT); }
__device__ __forceinline__ unsigned xb_add(unsigned* p, unsigned v) { return __hip_atomic_fetch_add(p, v, __ATOMIC_RELAXED, __HIP_MEMORY_SCOPE_AGENT); }
__device__ __forceinline__ unsigned xb_xcc_id() { return (unsigned)__builtin_amdgcn_s_getreg((3 << 11) | 20) & 0xFu; }
#define XB_SPIN(cond, bar) do { unsigned _sp = 0; while (cond) { __builtin_amdgcn_s_sleep(1); \
    if ((++_sp & 255u) == 0u) { if (xb_ld(&(bar)[XB_TMO])) break; if (_sp > XB_SPIN_CAP) { atomicAdd(&(bar)[XB_TMO], 1u); break; } } } } while (0)

struct XcdBarrier {
    unsigned* bar; unsigned x;
    volatile LAS unsigned* st;
};

__device__ __forceinline__ XcdBarrier xcd_barrier_post(unsigned* bar, volatile LAS unsigned* st) {
    XcdBarrier b; b.bar = bar; b.x = xb_xcc_id(); b.st = st;
    if (threadIdx.x == 0) (void)xb_add(&bar[XB_XCNT(b.x)], 1u);
    return b;
}
__device__ __forceinline__ void xcd_barrier_complete(unsigned* bar, unsigned x, unsigned& nloc, unsigned& nx) {
    const unsigned G = gridDim.x * gridDim.y * gridDim.z;
    unsigned sum, cnt, mine, sp = 0u;
    for (;;) {
        sum = 0u; cnt = 0u; mine = 0u;
#pragma unroll
        for (unsigned j = 0; j < 16; ++j) { const unsigned c = xb_ld(&bar[XB_XCNT(j)]); sum += c; cnt += (c > 0u) ? 1u : 0u; mine = (j == x) ? c : mine; }
        if (sum == G) break;
        __builtin_amdgcn_s_sleep(1);
        if ((++sp & 255u) == 0u) { if (xb_ld(&bar[XB_TMO])) break; if (sp > XB_SPIN_CAP) { atomicAdd(&bar[XB_TMO], 1u); break; } }
    }
    nloc = mine > 0u ? mine : 1u; nx = cnt > 0u ? cnt : 1u;
}

__device__ __forceinline__ void xcd_barrier(const XcdBarrier& b) {
    asm volatile("s_waitcnt vmcnt(0)" ::: "memory");
    __syncthreads();
    if (threadIdx.x == 0) {
        unsigned* bar = b.bar;
        __builtin_amdgcn_s_waitcnt(0);
        unsigned nloc = b.st[0], nx = b.st[1];
        if (nloc == 0u) { xcd_barrier_complete(bar, b.x, nloc, nx); b.st[0] = nloc; b.st[1] = nx; }
        const unsigned old = xb_add(&bar[XB_XSUB(b.x)], 1u);
        const unsigned gen = old / nloc;
        if (old + 1u == (gen + 1u) * nloc) {
            __builtin_amdgcn_fence(__ATOMIC_RELEASE, "agent");
            asm volatile("s_waitcnt vmcnt(0)" ::: "memory");
            const unsigned og = xb_add(&bar[XB_TOP], 1u);
            const unsigned tg = og / nx;
            if (og + 1u == (tg + 1u) * nx) xb_add(&bar[XB_TOPGEN], 1u);
            else XB_SPIN(xb_ld(&bar[XB_TOPGEN]) == tg, bar);
            __builtin_amdgcn_fence(__ATOMIC_ACQUIRE, "agent");
            xb_add(&bar[XB_XGEN(b.x)], 1u);
            asm volatile("s_waitcnt vmcnt(0)" ::: "memory");
        } else {
            XB_SPIN(xb_ld(&bar[XB_XGEN(b.x)]) == gen, bar);
            __builtin_amdgcn_fence(__ATOMIC_ACQUIRE, "agent");
            asm volatile("s_waitcnt vmcnt(0)" ::: "memory");
        }
    }
    __syncthreads();
}


__global__ void __launch_bounds__(512, 2) mega(P p) {
  extern __shared__ __attribute__((aligned(16))) char lds[];
  __shared__ uint4 xb_words;
  if (threadIdx.x == 0) xb_words = make_uint4(0u, 0u, 0u, 0u);
  __syncthreads();
  const XcdBarrier xb = xcd_barrier_post(p.xbar, (volatile LAS unsigned*)&xb_words);
  for (int ph = p.pb; ph < p.pe; ++ph) {
    if (ph == 0) phase_prep(p, lds);
    else if (ph == 1) phase_h0(p);
    else {
      const int l = (ph - 2) >> 2, s = (ph - 2) & 3;
      if (s == 0) { for (int rr = 0; rr < REP_INPROJ; ++rr) { if (rr) cg::this_grid().sync(); phase_inproj(p, l, lds); } }
      else if (s == 1) { for (int rr = 0; rr < REP_MIX; ++rr) { if (rr) cg::this_grid().sync(); phase_mix(p, l, rr, lds); } }
      else if (s == 2) { for (int rr = 0; rr < REP_OUT; ++rr) { if (rr) cg::this_grid().sync(); phase_outproj(p, l, lds); } }
      else phase_ln(p, l);
    }
    if (ph + 1 < p.pe) {
      if (p.pe < 0) cg::this_grid().sync();
      xcd_barrier(xb);
    }
  }
}

extern "C" void kernel_launch(void* const* d_in, const int* in_sizes, int n_in, void* d_out, int out_size, void* d_ws,
                              size_t ws_size, hipStream_t stream) {
  static int grid_blocks = 0;
  if (!grid_blocks) {
    int dev = 0, cus = 0, per_cu = 0;
    hipGetDevice(&dev);
    hipDeviceGetAttribute(&cus, hipDeviceAttributeMultiprocessorCount, dev);
    hipFuncSetAttribute((const void*)mega, hipFuncAttributeMaxDynamicSharedMemorySize, LDS_BYTES);
    hipOccupancyMaxActiveBlocksPerMultiprocessor(&per_cu, (const void*)mega, NT, LDS_BYTES);
    per_cu = 1;
    grid_blocks = cus * per_cu;
  }
  P p{};
  p.x = (const float*)d_in[0]; p.c = (const float*)d_in[1]; p.ctx = (const float*)d_in[2]; p.c_ctx = (const float*)d_in[3];
  p.w_in = (const float*)d_in[4]; p.w_out = (const float*)d_in[5]; p.w_ada = (const float*)d_in[6]; p.b_ada = (const float*)d_in[7];
  p.ln_g = (const float*)d_in[8]; p.ln_b = (const float*)d_in[9]; p.lb_logits = (const float*)d_in[10];
  p.hg_norm_g = (const float*)d_in[11]; p.ga_qn = (const float*)d_in[12]; p.ga_kn = (const float*)d_in[13];
  p.df_lam = (const float*)d_in[14]; p.df_subln = (const float*)d_in[15]; p.wn_sink = (const float*)d_in[16];
  p.out = (float*)d_out;
  char* ws = (char*)d_ws;
  size_t off = 0;
  auto take = [&](size_t bytes) { char* q = ws + off; off += (bytes + 255) & ~(size_t)255; return q; };
  p.ctr = (int*)take(256);
  p.xbar = (unsigned*)take(16384);
  p.mod = (float*)take((size_t)2 * 17 * 3072 * 4);
  p.Wt = (u16*)take((size_t)2 * NIN * 1024 * 2);
  p.Wot = (u16*)take((size_t)2 * 1024 * 1024 * 2);
  p.H = (u16*)take((size_t)MALL * 1024 * 2);
  p.G = (u16*)take((size_t)MALL * 1024 * 2);
  p.OF = (float*)take((size_t)NB * 4 * T * 64 * 4);
  p.OB = (float*)take((size_t)NB * 4 * T * 64 * 4);
  p.slab = (u16*)take((size_t)44 * 16 * T * 64 * 2);
  if (off > ws_size) { fprintf(stderr, "workspace too small: need %zu have %zu\n", off, ws_size); return; }
  hipMemsetAsync(p.ctr, 0, 256 + 16384, stream);
#if MULTI_LAUNCH
  for (int ph = 0; ph < NPHASE; ++ph) {
    p.pb = ph; p.pe = ph + 1;
    hipLaunchKernelGGL(mega, dim3(grid_blocks), dim3(NT), LDS_BYTES, stream, p);
  }
#else
  p.pb = 0; p.pe = NPHASE;
  void* args[] = {&p};
  hipError_t e = hipLaunchCooperativeKernel((const void*)mega, dim3(grid_blocks), dim3(NT), args, LDS_BYTES, stream);
  if (e != hipSuccess) fprintf(stderr, "cooperative launch failed: %s (grid %d)\n", hipGetErrorString(e), grid_blocks);
#endif
}
```
